# Optimizing an MI355X kernel written in HIP

```python
import math
import jax, jax.numpy as jnp
from jax import lax
import numpy as np

D_MODEL = 4096
BATCH = 4
SEQ = 4096
DEPTH = 1

N_META = 16
HEAD_DIM = 64
N_Q_HEADS = 32
N_KV_HEADS = 4
Q_PER_KV = N_Q_HEADS // N_KV_HEADS
ATTN_WIDTH = N_Q_HEADS * HEAD_DIM
KV_WIDTH = N_KV_HEADS * HEAD_DIM
WINDOW = 128
BLOCK = 128
ATTN_SCALE = HEAD_DIM ** -0.5
ROPE_DIM = HEAD_DIM // 4
ROPE_THETA = 500000.0
NEG_INF = -1e30
POOL_WINDOWS = (2, 4, 8, 16)
N_POOL_GROUPS = len(POOL_WINDOWS)
POOL_WIDTH = D_MODEL // 2
POOL_GROUP_WIDTH = POOL_WIDTH // N_POOL_GROUPS
N_BRANCHES = 2
IN_WIDTH = ATTN_WIDTH + 2 * KV_WIDTH + POOL_WIDTH + N_BRANCHES * D_MODEL
SPLITS = [ATTN_WIDTH, ATTN_WIDTH + KV_WIDTH, ATTN_WIDTH + 2 * KV_WIDTH,
          ATTN_WIDTH + 2 * KV_WIDTH + POOL_WIDTH]
D_FF = -(-8 * D_MODEL // 768) * 256
DN_ALPHA = (2 * DEPTH) ** 0.25
DN_BETA = (8 * DEPTH) ** -0.25
LN_EPS = 1e-5

kernel_name = "hybrid_swa_sinks_multiscale_pool_gated_deepnorm"


def layer_norm(x, g, b):
    xf = x.astype(jnp.float32)
    mu = xf.mean(-1, keepdims=True)
    var = jnp.square(xf - mu).mean(-1, keepdims=True)
    y = (xf - mu) * lax.rsqrt(var + LN_EPS)
    return (y * g.astype(jnp.float32) + b.astype(jnp.float32)).astype(x.dtype)


def partial_rope(x, pos):
    half = ROPE_DIM // 2
    inv_freq = ROPE_THETA ** (-jnp.arange(half, dtype=jnp.float32) * 2.0 / ROPE_DIM)
    ang = pos.astype(jnp.float32)[:, None] * inv_freq[None, :]
    cos = jnp.cos(ang)[None, :, None, :]
    sin = jnp.sin(ang)[None, :, None, :]
    xr = x[..., :ROPE_DIM].astype(jnp.float32)
    x1, x2 = xr[..., :half], xr[..., half:]
    rot = jnp.concatenate([x1 * cos - x2 * sin, x2 * cos + x1 * sin], axis=-1).astype(x.dtype)
    return jnp.concatenate([rot, x[..., ROPE_DIM:]], axis=-1)


def _band_blocks(a, nb):
    B = a.shape[0]
    ab = a.reshape(B, nb, BLOCK, N_KV_HEADS, HEAD_DIM)
    prev = jnp.pad(ab[:, :-1], ((0, 0), (1, 0), (0, 0), (0, 0), (0, 0)))
    return jnp.concatenate([prev, ab], axis=2)


def sliding_window_attention(q, k, v, sinks):
    B, T = q.shape[0], q.shape[1]
    lead = (-N_META) % BLOCK
    tail = (-(lead + T)) % BLOCK
    Tp = lead + T + tail
    nb = Tp // BLOCK
    pad = ((0, 0), (lead, tail), (0, 0), (0, 0))
    qb = jnp.pad(q, pad).reshape(B, nb, BLOCK, N_KV_HEADS, Q_PER_KV, HEAD_DIM)
    kb = _band_blocks(jnp.pad(k, pad), nb)
    vb = _band_blocks(jnp.pad(v, pad), nb)
    k_meta, v_meta = k[:, :N_META], v[:, :N_META]

    s_band = jnp.einsum('bnqkgd,bnskd->bnkgqs', qb, kb).astype(jnp.float32) * ATTN_SCALE
    s_meta = jnp.einsum('bnqkgd,bmkd->bnkgqm', qb, k_meta).astype(jnp.float32) * ATTN_SCALE

    blk = jnp.arange(nb)
    q_idx = blk[:, None] * BLOCK + jnp.arange(BLOCK)[None, :]
    k_idx = (blk[:, None] - 1) * BLOCK + jnp.arange(2 * BLOCK)[None, :]
    diff = q_idx[:, :, None] - k_idx[:, None, :]
    band_ok = (diff >= 0) & (diff < WINDOW) & (k_idx[:, None, :] >= lead + N_META)
    meta_ok = q_idx[:, :, None] >= lead + jnp.arange(N_META)[None, None, :]
    s_band = jnp.where(band_ok[None, :, None, None], s_band, NEG_INF)
    s_meta = jnp.where(meta_ok[None, :, None, None], s_meta, NEG_INF)

    sink = sinks.astype(jnp.float32).reshape(N_KV_HEADS, Q_PER_KV)[None, None, :, :, None, None]
    m = jnp.maximum(jnp.maximum(s_band.max(-1, keepdims=True), s_meta.max(-1, keepdims=True)), sink)
    p_band = jnp.exp(s_band - m)
    p_meta = jnp.exp(s_meta - m)
    inv = 1.0 / (p_band.sum(-1, keepdims=True) + p_meta.sum(-1, keepdims=True) + jnp.exp(sink - m))
    o = (jnp.einsum('bnkgqs,bnskd->bnqkgd', (p_band * inv).astype(v.dtype), vb)
         + jnp.einsum('bnkgqm,bmkd->bnqkgd', (p_meta * inv).astype(v.dtype), v_meta))
    return o.reshape(B, Tp, ATTN_WIDTH)[:, lead:lead + T]


def multiscale_pool(u, w_grp, scale):
    B, T = u.shape[0], u.shape[1]
    ug = u.reshape(B, T, N_POOL_GROUPS, POOL_GROUP_WIDTH)
    cs = jnp.cumsum(ug.astype(jnp.float32), axis=1)
    cs = jnp.pad(cs, ((0, 0), (1, 0), (0, 0), (0, 0)))
    t = jnp.arange(T)
    outs = []
    for g, w in enumerate(POOL_WINDOWS):
        csg = cs[:, :, g]
        start = jnp.maximum(t + 1 - w, 0)
        win_sum = csg[:, 1:] - csg[:, start]
        count = jnp.minimum(t + 1, w).astype(jnp.float32)[None, :, None]
        outs.append(win_sum / count - ug[:, :, g].astype(jnp.float32))
    pooled = jnp.stack(outs, axis=2).astype(u.dtype)
    mixed = jnp.einsum('btgc,gcd->btgd', pooled, w_grp)
    return mixed.reshape(B, T, POOL_WIDTH) * scale


def setup_inputs(seed: int = 0) -> dict:
    key = jax.random.key(seed)
    ks = jax.random.split(key, 20)
    f32 = jnp.float32

    def nrm(k, shape, s):
        return jax.random.normal(k, shape, f32) * s

    return {
        "x": nrm(ks[0], (BATCH, SEQ, D_MODEL), 1.0),
        "meta_tokens": nrm(ks[1], (N_META, D_MODEL), 1.0),
        "ln_in_g": 1.0 + nrm(ks[2], (D_MODEL,), 0.02),
        "ln_in_b": nrm(ks[3], (D_MODEL,), 0.02),
        "w_in": nrm(ks[4], (DEPTH, D_MODEL, IN_WIDTH), D_MODEL ** -0.5),
        "b_gate": nrm(ks[5], (DEPTH, N_BRANCHES, D_MODEL), 0.1),
        "attn_sinks": nrm(ks[6], (DEPTH, N_Q_HEADS), 0.5),
        "w_attn_up": nrm(ks[7], (DEPTH, ATTN_WIDTH, D_MODEL), ATTN_WIDTH ** -0.5),
        "w_pool_grp": nrm(ks[8], (DEPTH, N_POOL_GROUPS, POOL_GROUP_WIDTH, POOL_GROUP_WIDTH), POOL_GROUP_WIDTH ** -0.5),
        "pool_scale": 1.0 + nrm(ks[9], (DEPTH, POOL_WIDTH), 0.02),
        "w_pool_up": nrm(ks[10], (DEPTH, POOL_WIDTH, D_MODEL), POOL_WIDTH ** -0.5),
        "w_out": nrm(ks[11], (DEPTH, D_MODEL, D_MODEL), DN_BETA * D_MODEL ** -0.5),
        "ln1_g": 1.0 + nrm(ks[12], (DEPTH, D_MODEL), 0.02),
        "ln1_b": nrm(ks[13], (DEPTH, D_MODEL), 0.02),
        "w_ffn_in": nrm(ks[14], (DEPTH, D_MODEL, 2 * D_FF), D_MODEL ** -0.5),
        "w_ffn_down": nrm(ks[15], (DEPTH, D_FF, D_MODEL), DN_BETA * D_FF ** -0.5),
        "ln2_g": 1.0 + nrm(ks[16], (DEPTH, D_MODEL), 0.02),
        "ln2_b": nrm(ks[17], (DEPTH, D_MODEL), 0.02),
    }


def reference(x, meta_tokens, ln_in_g, ln_in_b, w_in, b_gate, attn_sinks, w_attn_up,
              w_pool_grp, pool_scale, w_pool_up, w_out, ln1_g, ln1_b, w_ffn_in,
              w_ffn_down, ln2_g, ln2_b):
    B = x.shape[0]
    meta = jnp.broadcast_to(meta_tokens[None].astype(x.dtype), (B, N_META, D_MODEL))
    h = layer_norm(jnp.concatenate([meta, x], axis=1), ln_in_g, ln_in_b)
    T = h.shape[1]
    pos = jnp.arange(T)

    for l in range(DEPTH):
        proj = h @ w_in[l]
        q, k, v, u, gate_logits = jnp.split(proj, SPLITS, axis=-1)
        q = partial_rope(q.reshape(B, T, N_Q_HEADS, HEAD_DIM), pos)
        k = partial_rope(k.reshape(B, T, N_KV_HEADS, HEAD_DIM), pos)
        v = v.reshape(B, T, N_KV_HEADS, HEAD_DIM)

        a_out = sliding_window_attention(q, k, v, attn_sinks[l]) @ w_attn_up[l]
        p_out = multiscale_pool(u, w_pool_grp[l], pool_scale[l]) @ w_pool_up[l]

        gates = jax.nn.sigmoid(gate_logits.reshape(B, T, N_BRANCHES, D_MODEL) + b_gate[l])
        mixed = gates[:, :, 0] * a_out + gates[:, :, 1] * p_out
        h = layer_norm(DN_ALPHA * h + mixed @ w_out[l], ln1_g[l], ln1_b[l])

        f_gate, f_up = jnp.split(h @ w_ffn_in[l], 2, axis=-1)
        ffn = (jax.nn.silu(f_gate) * f_up) @ w_ffn_down[l]
        h = layer_norm(DN_ALPHA * h + ffn, ln2_g[l], ln2_b[l])

    return h[:, N_META:]
```

```cpp
#include <hip/hip_runtime.h>
#include <cstdio>
#include <cstdint>

namespace pg8 {
#define PG8_LAS __attribute__((address_space(3)))
typedef unsigned short bf16_t;
typedef short bf16x8 __attribute__((ext_vector_type(8)));
typedef float f32x4 __attribute__((ext_vector_type(4)));
typedef unsigned u32x4 __attribute__((ext_vector_type(4)));
typedef int i32x4 __attribute__((ext_vector_type(4)));
typedef int i32x8 __attribute__((ext_vector_type(8)));
constexpr int BM = 256, BK = 64, HALF = 128, HTB = HALF * BK * 2  , STAGE_BYTES = 8 * HTB, NXCD = 8, WGM = 8;

__host__ __device__ __forceinline__ int lds_byte(int r, int c) { const int st = (r >> 4) * 2 + (c >> 5), rr = r & 15, cc = c & 31, ob = rr * 64 + cc * 2; return st * 1024 + (ob ^ (((ob >> 9) & 1) << 5)); }
__host__ __device__ __forceinline__ void stage_rc(int b, int& R, int& C) { const int st = b / 1024, sb = b % 1024, swz = sb ^ (((sb >> 9) & 1) << 5); R = (st >> 1) * 16 + swz / 64; C = (st & 1) * 32 + (swz % 64) / 2; }
__host__ __device__ __forceinline__ int perm32(int rho) { const int n = rho >> 4, i = rho & 15; return 8 * (i >> 2) + 4 * n + (i & 3); }

struct Unit { int pm, pn, z; };
struct Gemm { int K, lda, ldb; };

__device__ __forceinline__ void tile_of(int L, int nM, int nN, int& pm, int& pn, int wgm = WGM) {
    const int nwg = nM * nN; int wgid = L;
    { const int q = nwg / NXCD, r = nwg % NXCD, xcd = wgid % NXCD, off = wgid / NXCD; wgid = (xcd < r ? xcd * (q + 1) : r * (q + 1) + (xcd - r) * q) + off; }
    const int nig = wgm * nN, gid = wgid / nig, fm = gid * wgm, gsz = (nM - fm) < wgm ? (nM - fm) : wgm;
    pm = fm + ((wgid % nig) % gsz); pn = (wgid % nig) / gsz;
}

__device__ __forceinline__ unsigned cvt_pk_bf16(float lo, float hi) { unsigned r; asm volatile("s_nop 0\n\tv_cvt_pk_bf16_f32 %0, %1, %2" : "=v"(r) : "v"(lo), "v"(hi)); return r; }
__device__ __forceinline__ float bf_lo(unsigned w) { return __uint_as_float(w << 16); }
__device__ __forceinline__ float bf_hi(unsigned w) { return __uint_as_float(w & 0xffff0000u); }
__device__ __forceinline__ float sigmoidf_fast(float x) { return __builtin_amdgcn_rcpf(1.0f + __builtin_amdgcn_exp2f(-1.44269504f * x)); }

template <class Epi, class Sched, bool ALIGN_EPI = false, bool SP2 = false, bool FP8 = false, int MIX = 0>
__device__ __forceinline__ void gemm_phase(PG8_LAS unsigned char* lds, const Gemm g, const Sched& S, const Epi& E) {
    int tid = threadIdx.x; asm volatile("" : "+v"(tid));
    const int wid = __builtin_amdgcn_readfirstlane(tid >> 6), lane = tid & 63, wr = wid >> 2, wc = wid & 3, fr = lane & 15, fq = lane >> 4;
    const int K = g.K, nt = K / BK;
    unsigned voffA[2], voffB[2];
#pragma unroll
    for (int i = 0; i < 2; ++i) { int R, C; stage_rc(tid * 16 + i * 8192, R, C); const int Rb = Epi::PERM ? ((R & ~31) + perm32(R & 31)) : R;
        voffA[i] = (unsigned)(R * g.lda + C) * 2u; voffB[i] = (unsigned)(Rb * g.ldb + C) * 2u; }
    const size_t kstep = (size_t)(BK * 2);
    const size_t hstepA = (size_t)HALF * g.lda * 2, hstepB = (size_t)HALF * g.ldb * 2;
    const unsigned ldsw = (unsigned)wid * 1024u;
    const int aoff = lds_byte(wr * 64 + fr, fq * 8), boff = lds_byte(wc * 32 + fr, fq * 8);
#define PG8_SA(b, h) (((b) * 2 + (h)) * HTB)
#define PG8_SB(b, h) ((4 + (b) * 2 + (h)) * HTB)
#define PG8_STAGE(bufoff, gbase, voff) do { _Pragma("unroll") for (int _i = 0; _i < 2; ++_i) \
        __builtin_amdgcn_global_load_lds((const unsigned*)((const char*)(gbase) + (voff)[_i]), (PG8_LAS unsigned*)(lds + (bufoff) + ldsw + _i * 8192), 16, 0, 0); } while (0)
#define PG8_LDA(dst, b, h) do { _Pragma("unroll") for (int m = 0; m < 4; ++m) _Pragma("unroll") for (int k = 0; k < 2; ++k) dst[m][k] = *(const PG8_LAS bf16x8*)(lds + PG8_SA(b, h) + aoff + m * 2048 + k * 1024); } while (0)
#define PG8_LDB(dst, b, h) do { _Pragma("unroll") for (int n = 0; n < 2; ++n) _Pragma("unroll") for (int k = 0; k < 2; ++k) dst[n][k] = *(const PG8_LAS bf16x8*)(lds + PG8_SB(b, h) + boff + n * 2048 + k * 1024); } while (0)
#define PG8_CAT8(x) __builtin_shufflevector(__builtin_bit_cast(i32x4, (x)[0]), __builtin_bit_cast(i32x4, (x)[1]), 0, 1, 2, 3, 4, 5, 6, 7)
#define PG8_MMA(ai, bj, At, Bt, F8) do { __builtin_amdgcn_s_setprio(1); _Pragma("unroll") for (int m = 0; m < 4; ++m) _Pragma("unroll") for (int n = 0; n < 2; ++n) { \
        if constexpr ((F8) == 1) { _Pragma("unroll") for (int k = 0; k < 2; ++k) \
            asm volatile("v_mfma_i32_16x16x64_i8 %0, %1, %2, %0" : "+v"(acc[ai][bj][m][n]) : "v"(Bt[n][k]), "v"(At[m][k]) : "memory"); }     \
        else { _Pragma("unroll") for (int k = 0; k < 2; ++k) acc[ai][bj][m][n] = __builtin_amdgcn_mfma_f32_16x16x32_bf16(Bt[n][k], At[m][k], acc[ai][bj][m][n], 0, 0, 0); } } \
        __builtin_amdgcn_s_setprio(0); } while (0)
#define PG8_SP2BODY(F8) do { \
            PG8_LDB(B0, 0, 0); PG8_LDB(B1, 0, 1); PG8_SCHED; PG8_LDA(At, 0, 0); PG8_STAGE(PG8_SA(1, 1), a1 + hstepA, voffA); \
            PG8_WAIT_V(8); PG8_WAIT_L(0); PG8_BAR; PG8_MMA(0, 0, At, B0, F8); PG8_MMA(0, 1, At, B1, F8); PG8_BAR; PG8_SCHED; \
            PG8_LDA(At, 0, 1); PG8_STAGE(PG8_SB(0, 0), b2, voffB); PG8_STAGE(PG8_SB(0, 1), b2 + hstepB, voffB); PG8_STAGE(PG8_SA(0, 0), a2, voffA); \
            PG8_WAIT_V(8); PG8_WAIT_L(0); PG8_BAR; PG8_MMA(1, 0, At, B0, F8); PG8_MMA(1, 1, At, B1, F8); PG8_BAR; PG8_SCHED; \
            PG8_LDB(B0, 1, 0); PG8_LDB(B1, 1, 1); PG8_SCHED; PG8_LDA(At, 1, 0); PG8_STAGE(PG8_SA(0, 1), a2 + hstepA, voffA); \
            PG8_WAIT_V(8); PG8_WAIT_L(0); PG8_BAR; PG8_MMA(0, 0, At, B0, F8); PG8_MMA(0, 1, At, B1, F8); PG8_BAR; PG8_SCHED; \
            PG8_LDA(At, 1, 1); PG8_STAGE(PG8_SB(1, 0), b3, voffB); PG8_STAGE(PG8_SB(1, 1), b3 + hstepB, voffB); PG8_STAGE(PG8_SA(1, 0), a3, voffA); \
            PG8_WAIT_V(8); PG8_WAIT_L(0); PG8_BAR; PG8_MMA(1, 0, At, B0, F8); PG8_MMA(1, 1, At, B1, F8); PG8_BAR; PG8_SCHED; } while (0)
#define PG8_WAIT_V(n) asm volatile("s_waitcnt vmcnt(" #n ")" ::: "memory")
#define PG8_WAIT_L(n) asm volatile("s_waitcnt lgkmcnt(" #n ")" ::: "memory")
#define PG8_BAR __builtin_amdgcn_s_barrier()
#define PG8_SCHED __builtin_amdgcn_sched_barrier(0)
    Unit cur, nxt; int ui = 0;
    if (!S.next(0, cur)) return;
    f32x4 acc[2][2][4][2];
#pragma unroll
    for (int a = 0; a < 2; ++a)
#pragma unroll
        for (int b = 0; b < 2; ++b)
#pragma unroll
            for (int m = 0; m < 4; ++m)
#pragma unroll
                for (int n = 0; n < 2; ++n) acc[a][b][m][n] = (f32x4){0.f, 0.f, 0.f, 0.f};
    int sc1_ = 0x7F7F7F7F; asm volatile("" : "+v"(sc1_));
    bf16x8 At[4][2], B0[2][2], B1[2][2];
    const char* cA; const char* cB; S.ptrs(cur, cA, cB);
    if constexpr (SP2) {
        PG8_STAGE(PG8_SB(0, 0), cB, voffB); PG8_STAGE(PG8_SB(0, 1), cB + hstepB, voffB); PG8_STAGE(PG8_SA(0, 0), cA, voffA); PG8_STAGE(PG8_SA(0, 1), cA + hstepA, voffA);
        if (wr == 1) PG8_BAR;
        PG8_WAIT_V(2); PG8_BAR;
        PG8_STAGE(PG8_SB(1, 0), cB + kstep, voffB); PG8_STAGE(PG8_SA(1, 0), cA + kstep, voffA); PG8_STAGE(PG8_SB(1, 1), cB + hstepB + kstep, voffB);
        PG8_WAIT_V(6); PG8_BAR;
    } else {
        PG8_STAGE(PG8_SB(0, 0), cB, voffB); PG8_STAGE(PG8_SA(0, 0), cA, voffA); PG8_STAGE(PG8_SB(0, 1), cB + hstepB, voffB); PG8_STAGE(PG8_SA(0, 1), cA + hstepA, voffA);
        if (wr == 1) PG8_BAR;
        PG8_WAIT_V(4); PG8_BAR;
        PG8_STAGE(PG8_SB(1, 0), cB + kstep, voffB); PG8_STAGE(PG8_SA(1, 0), cA + kstep, voffA); PG8_STAGE(PG8_SB(1, 1), cB + hstepB + kstep, voffB);
        PG8_WAIT_V(6); PG8_BAR;
    }
    for (;;) {
        const bool has_next = S.next(ui + 1, nxt);
        const char* nA = cA; const char* nB = cB; if (has_next) S.ptrs(nxt, nA, nB);
#define PG8_TLOOP_HEAD(CA, CB, NA, NB, NTC) for (int t = 0; t < (NTC); t += 2) { \
            const bool last = (t == (NTC) - 2); \
            const char* a1 = (CA) + (size_t)(t + 1) * kstep; \
            const char* a2 = last ? (NA) : (CA) + (size_t)(t + 2) * kstep; const char* b2 = last ? (NB) : (CB) + (size_t)(t + 2) * kstep; \
            const char* a3 = a2 + kstep; const char* b3 = b2 + kstep;
#define PG8_EPI_CALL(call) do { asm volatile("s_nop 15\n\ts_nop 15" ::: "memory"); if constexpr (ALIGN_EPI) { if (wr == 0) PG8_BAR; } call; if constexpr (ALIGN_EPI) { if (wr == 1) PG8_BAR; } } while (0)
#define PG8_ZERO_ACC do { _Pragma("unroll") for (int a = 0; a < 2; ++a) _Pragma("unroll") for (int b = 0; b < 2; ++b) _Pragma("unroll") for (int m = 0; m < 4; ++m) _Pragma("unroll") for (int n = 0; n < 2; ++n) acc[a][b][m][n] = (f32x4){0.f, 0.f, 0.f, 0.f}; } while (0)
        if constexpr (MIX == 2) {
            const char* mA; const char* mB; S.ptrs2(cur, mA, mB);
            PG8_TLOOP_HEAD(cA, cB, mA, mB, Sched::NT0) PG8_SP2BODY(1); }
            PG8_EPI_CALL(E.mid(acc, cur, wr, wc, fr, fq));
            PG8_TLOOP_HEAD(mA, mB, nA, nB, nt) PG8_SP2BODY(0); }
        } else if constexpr (MIX == 1) {
            const char *g2B, *fA, *fB, *mA, *mB; S.ptrs_all(cur, g2B, fA, fB, mA, mB);
            PG8_TLOOP_HEAD(cA, cB, cA, g2B, nt) PG8_SP2BODY(1); }
            PG8_EPI_CALL(E.gate(acc, cur, 0, wr, wc, fr, fq)); PG8_ZERO_ACC;
            PG8_TLOOP_HEAD(cA, g2B, fA, fB, nt) PG8_SP2BODY(1); }
            PG8_EPI_CALL(E.gate(acc, cur, 1, wr, wc, fr, fq)); PG8_ZERO_ACC;
            PG8_TLOOP_HEAD(fA, fB, mA, mB, nt >> 1) PG8_SP2BODY(1); }
            PG8_EPI_CALL(E.mid(acc, cur, wr, wc, fr, fq));
            PG8_TLOOP_HEAD(mA, mB, nA, nB, nt) PG8_SP2BODY(0); }
        } else {
        PG8_TLOOP_HEAD(cA, cB, nA, nB, nt)
            if constexpr (SP2) {
            PG8_SP2BODY(FP8 ? 1 : 0);
            } else {
            PG8_LDB(B0, 0, 0); PG8_SCHED; PG8_LDA(At, 0, 0); PG8_STAGE(PG8_SA(1, 1), a1 + hstepA, voffA);
            PG8_WAIT_L(8); PG8_BAR; PG8_WAIT_L(0); PG8_MMA(0, 0, At, B0, FP8); PG8_BAR; PG8_SCHED;
            PG8_LDB(B1, 0, 1); PG8_STAGE(PG8_SB(0, 0), b2, voffB);
            PG8_BAR; PG8_WAIT_L(0); PG8_MMA(0, 1, At, B1, FP8); PG8_BAR;
            PG8_LDA(At, 0, 1); PG8_STAGE(PG8_SA(0, 0), a2, voffA);
            PG8_BAR; PG8_WAIT_L(0); PG8_MMA(1, 0, At, B0, FP8); PG8_BAR; PG8_SCHED;
            PG8_STAGE(PG8_SB(0, 1), b2 + hstepB, voffB);
            PG8_WAIT_V(6); PG8_BAR; PG8_MMA(1, 1, At, B1, FP8); PG8_BAR;
            PG8_LDB(B0, 1, 0); PG8_SCHED; PG8_LDA(At, 1, 0); PG8_STAGE(PG8_SA(0, 1), a2 + hstepA, voffA);
            PG8_WAIT_L(8); PG8_BAR; PG8_WAIT_L(0); PG8_MMA(0, 0, At, B0, FP8); PG8_BAR; PG8_SCHED;
            PG8_LDB(B1, 1, 1); PG8_STAGE(PG8_SB(1, 0), b3, voffB);
            PG8_BAR; PG8_WAIT_L(0); PG8_MMA(0, 1, At, B1, FP8); PG8_BAR;
            PG8_LDA(At, 1, 1); PG8_STAGE(PG8_SA(1, 0), a3, voffA);
            PG8_BAR; PG8_WAIT_L(0); PG8_MMA(1, 0, At, B0, FP8); PG8_BAR; PG8_SCHED;
            PG8_STAGE(PG8_SB(1, 1), b3 + hstepB, voffB);
            PG8_WAIT_V(6); PG8_BAR; PG8_MMA(1, 1, At, B1, FP8); PG8_BAR;
            }
        }
        }
#undef PG8_TLOOP_HEAD
#undef PG8_EPI_CALL
#undef PG8_ZERO_ACC
        if constexpr (FP8) asm volatile("s_nop 15\n\ts_nop 15" ::: "memory");
        if constexpr (ALIGN_EPI) { if (wr == 0) PG8_BAR; }
        E(acc, cur, wr, wc, fr, fq);
        if (!has_next) break;
        {
#pragma unroll
        for (int a = 0; a < 2; ++a)
#pragma unroll
            for (int b = 0; b < 2; ++b)
#pragma unroll
                for (int m = 0; m < 4; ++m)
#pragma unroll
                    for (int n = 0; n < 2; ++n) acc[a][b][m][n] = (f32x4){0.f, 0.f, 0.f, 0.f};
        }
        cur = nxt; cA = nA; cB = nB; ++ui;
        if constexpr (ALIGN_EPI) { if (wr == 1) PG8_BAR; }
    }
    PG8_WAIT_V(0);
    if constexpr (!ALIGN_EPI) { if (wr == 0) PG8_BAR; }
    PG8_BAR;
#undef PG8_SA
#undef PG8_SB
#undef PG8_STAGE
#undef PG8_LDA
#undef PG8_LDB
#undef PG8_MMA
#undef PG8_SP2BODY
#undef PG8_CAT8
#undef PG8_WAIT_V
#undef PG8_WAIT_L
#undef PG8_BAR
#undef PG8_SCHED
}
}

#ifndef PG8_SP2
#define PG8_SP2 true
#endif
#ifndef PG8_ALIGN
#define PG8_ALIGN true
#endif

constexpr int NWAVES = 8;
constexpr int BATCH = 4, SEQ = 4096, D = 4096, NMETA = 16;
constexpr int M = BATCH * SEQ;
constexpr int MX = M + 256;
constexpr int AW = 2048, KVW = 256, PW = 2048, INW = 12800;
constexpr int FF = 11008;
constexpr float LN_EPS = 1e-5f;
constexpr float DN_ALPHA = 1.189207115002721f;
constexpr int NPOS = SEQ + NMETA;

constexpr size_t MiB = 1u << 20;
constexpr size_t WS_CTL = 0, CTL_ZERO_BYTES = 1 * MiB;
constexpr size_t WS_ROPE = 1 * MiB;
constexpr size_t WS_WIN = 2 * MiB;
constexpr size_t WS_WAU = 102 * MiB;
constexpr size_t WS_WPG = 134 * MiB;
constexpr size_t WS_WOUT = 136 * MiB;
constexpr size_t WS_WFFI = 168 * MiB;
constexpr size_t WS_WFFD = 340 * MiB;
constexpr size_t WS_H = 426 * MiB;
constexpr size_t WS_Q = 556 * MiB;
constexpr size_t WS_K = 620 * MiB;
constexpr size_t WS_V = 629 * MiB;
constexpr size_t WS_U = 638 * MiB;
constexpr size_t WS_GA = 703 * MiB;
constexpr size_t WS_GSLAB = 703 * MiB;
constexpr size_t WS_WPT = 959 * MiB;
constexpr size_t WS_HLO = 768 * MiB;
constexpr size_t WS_H1Q = 2 * MiB;
constexpr size_t WS_POOLED = WS_WIN;
constexpr size_t WS_MIXED = WS_Q;
constexpr size_t WS_H1 = WS_H;
constexpr size_t WS_ACT = WS_GA;
constexpr size_t WS_XS1 = 1087 * MiB, WS_XS2 = 1089 * MiB;
constexpr size_t WS_H8 = 1092 * MiB;
constexpr size_t WS_WG8 = 1158 * MiB;
constexpr size_t WS_W8P = 1190 * MiB;
constexpr size_t WS_ATT8 = 976 * MiB;
constexpr size_t WS_W8AU = 1040 * MiB;
constexpr size_t WS_END = 1208 * MiB;
static_assert(WS_WPT + (size_t)D * PW * 2 <= WS_ATT8 && WS_ATT8 + (size_t)M * 4096 <= WS_W8AU && WS_W8AU + (size_t)D * 4096 <= WS_XS1, "P3 operand map");
static_assert(WS_WIN + (size_t)INW * D * 2 <= WS_WAU && WS_WFFI + (size_t)2 * FF * D * 2 <= WS_WFFD && WS_WFFD + (size_t)D * FF * 2 <= WS_H, "weights map");
static_assert(WS_H + (size_t)MX * D * 2 <= WS_Q && WS_K + (size_t)MX * KVW * 2 <= WS_V && WS_V + (size_t)MX * KVW * 2 <= WS_U && WS_U + (size_t)MX * PW * 2 <= WS_GA, "act map");
static_assert(WS_MIXED + (size_t)M * D * 2 <= WS_GA && WS_ACT + (size_t)M * FF * 2 <= WS_XS1 && WS_WPT + (size_t)D * PW * 2 <= WS_XS1, "overlay map");
constexpr int CW_BAR = 4096;
constexpr int CW_Q2 = 128, CW_TMO2 = 192;
constexpr int CW_PAN1 = 16384, CW_PAN2 = 16384 + 64 * 64;
constexpr size_t WS_ST0 = 1 * MiB + 512 * 1024;

constexpr int RING_OFF = 0, RING_BYTES = 131072;
constexpr int LDSCTL_OFF = RING_BYTES, MISC_OFF = LDSCTL_OFF + 320;
constexpr int LDS_BYTES = 147456;

#define GAS __attribute__((address_space(1)))
#define LAS __attribute__((address_space(3)))
typedef unsigned short bf16;
typedef unsigned v4u __attribute__((ext_vector_type(4)));
typedef unsigned v2u __attribute__((ext_vector_type(2)));
typedef float f32x4 __attribute__((ext_vector_type(4)));
typedef GAS unsigned gu32;
#define RLX_AGENT __ATOMIC_RELAXED, __HIP_MEMORY_SCOPE_AGENT
#define LDS_WAIT() asm volatile("s_waitcnt lgkmcnt(0)" ::: "memory")
#define VM_WAIT() asm volatile("s_waitcnt vmcnt(0)" ::: "memory")
__device__ __forceinline__ unsigned f2bf(float f) { unsigned u = __builtin_bit_cast(unsigned, f); return (u + 0x7fffu + ((u >> 16) & 1u)) >> 16; }
__device__ __forceinline__ unsigned pk2(float lo, float hi) { return pg8::cvt_pk_bf16(lo, hi); }

#define XB_TMO      128
#define XB_XCNT(j)  (256  + 64 * (j))
#define XB_XSUB(j)  (1280 + 64 * (j))
#define XB_XGEN(j)  (2304 + 64 * (j))
#define XB_TOP      3328
#define XB_TOPGEN   3392
#define XCD_BAR_WORDS 3456
#define XB_SPIN_CAP (1u << 18)

__device__ __forceinline__ unsigned xb_ld(unsigned* p)              { return __hip_atomic_load(p, __ATOMIC_RELAXED, __HIP_MEMORY_SCOPE_AGENT); }
__device__ __forceinline__ unsigned xb_add(unsigned* p, unsigned v) { return __hip_atomic_fetch_add(p, v, __ATOMIC_RELAXED, __HIP_MEMORY_SCOPE_AGENT); }
__device__ __forceinline__ unsigned xb_xcc_id() { return (unsigned)__builtin_amdgcn_s_getreg((3 << 11) | 20) & 0xFu; }
#define XB_SPIN(cond, bar) do { unsigned _sp = 0; while (cond) { __builtin_amdgcn_s_sleep(1); \
    if ((++_sp & 255u) == 0u) { if (xb_ld(&(bar)[XB_TMO])) break; if (_sp > XB_SPIN_CAP) { atomicAdd(&(bar)[XB_TMO], 1u); break; } } } } while (0)

struct XcdBarrier { unsigned* bar; unsigned x; volatile LAS unsigned* st; };

__device__ __forceinline__ XcdBarrier xcd_barrier_post(unsigned* bar, volatile LAS unsigned* st) {
    XcdBarrier b; b.bar = bar; b.x = xb_xcc_id(); b.st = st;
    if (threadIdx.x == 0) (void)xb_add(&bar[XB_XCNT(b.x)], 1u);
    return b;
}
__device__ __forceinline__ void xcd_barrier_complete(unsigned* bar, unsigned x, unsigned& nloc, unsigned& nx) {
    const unsigned G = gridDim.x * gridDim.y * gridDim.z;
    unsigned sum, cnt, mine, sp = 0u;
    for (;;) {
        sum = 0u; cnt = 0u; mine = 0u;
#pragma unroll
        for (unsigned j = 0; j < 16; ++j) { const unsigned c = xb_ld(&bar[XB_XCNT(j)]); sum += c; cnt += (c > 0u) ? 1u : 0u; mine = (j == x) ? c : mine; }
        if (sum == G) break;
        __builtin_amdgcn_s_sleep(1);
        if ((++sp & 255u) == 0u) { if (xb_ld(&bar[XB_TMO])) break; if (sp > XB_SPIN_CAP) { atomicAdd(&bar[XB_TMO], 1u); break; } }
    }
    nloc = mine > 0u ? mine : 1u; nx = cnt > 0u ? cnt : 1u;
}
__device__ __forceinline__ void xcd_barrier(const XcdBarrier& b) {
    asm volatile("s_waitcnt vmcnt(0)" ::: "memory");
    __syncthreads();
    if (threadIdx.x == 0) {
        unsigned* bar = b.bar;
        __builtin_amdgcn_s_waitcnt(0);
        unsigned nloc = b.st[0], nx = b.st[1];
        if (nloc == 0u) { xcd_barrier_complete(bar, b.x, nloc, nx); b.st[0] = nloc; b.st[1] = nx; }
        const unsigned old = xb_add(&bar[XB_XSUB(b.x)], 1u);
        const unsigned gen = old / nloc;
        if (old + 1u == (gen + 1u) * nloc) {
            __builtin_amdgcn_fence(__ATOMIC_RELEASE, "agent");
            asm volatile("s_waitcnt vmcnt(0)" ::: "memory");
            const unsigned og = xb_add(&bar[XB_TOP], 1u);
            const unsigned tg = og / nx;
            if (og + 1u == (tg + 1u) * nx) xb_add(&bar[XB_TOPGEN], 1u);
            else XB_SPIN(xb_ld(&bar[XB_TOPGEN]) == tg, bar);
            __builtin_amdgcn_fence(__ATOMIC_ACQUIRE, "agent");
            xb_add(&bar[XB_XGEN(b.x)], 1u);
            asm volatile("s_waitcnt vmcnt(0)" ::: "memory");
        } else {
            XB_SPIN(xb_ld(&bar[XB_XGEN(b.x)]) == gen, bar);
            __builtin_amdgcn_fence(__ATOMIC_ACQUIRE, "agent");
            asm volatile("s_waitcnt vmcnt(0)" ::: "memory");
        }
    }
    __syncthreads();
}

struct Args { const float* in[18]; float* out; unsigned char* ws; };

struct Frame {
    LAS unsigned char* lds;
    volatile LAS unsigned* MISC;
    gu32* ctl;
    int tid, lane, wave, G;
};

__device__ __forceinline__ float wave_sum(float v) {
#pragma unroll
    for (int o = 1; o < 64; o <<= 1) v += __shfl_xor(v, o);
    return v;
}

__device__ __forceinline__ int drow_of(int n0, int mode) {
    int drow = n0;
    if (mode == 3) { const int gcol = n0 - 4608, br = gcol >> 12, ch = gcol & 4095; drow = 256 * (ch >> 7) + 128 * br + (ch & 127); }
    else if (mode == 2) { if (n0 < FF) drow = 256 * (n0 >> 7) + (n0 & 127); else { const int ch = n0 - FF; drow = 256 * (ch >> 7) + 128 + (ch & 127); } }
    return drow;
}
constexpr int KQ = 4096;
constexpr float H8_SCALE = 31.75f, W8_SCALE = 2032.0f, WAU8_SCALE = 1437.0f, G8_UNSCALE = 1.0f / (31.75f * 2032.0f), ATT8_SCALE = 100.0f, AU8_UNSCALE = 1.0f / (100.0f * 1437.0f);
__device__ __forceinline__ unsigned pk4_fp8(float a, float b, float c, float d) {
    const int ia = (int)__builtin_rintf(__builtin_amdgcn_fmed3f(a, -127.f, 127.f)), ib = (int)__builtin_rintf(__builtin_amdgcn_fmed3f(b, -127.f, 127.f));
    const int ic = (int)__builtin_rintf(__builtin_amdgcn_fmed3f(c, -127.f, 127.f)), id = (int)__builtin_rintf(__builtin_amdgcn_fmed3f(d, -127.f, 127.f));
    return (unsigned)(ia & 255) | ((unsigned)(ib & 255) << 8) | ((unsigned)(ic & 255) << 16) | ((unsigned)id << 24); }
__device__ __forceinline__ float lo_of(float x, float b) { const unsigned E = (__float_as_uint(b) >> 23) & 255u; const float sc = __uint_as_float((261u - E) << 23);
    return (E >= 16u && E <= 250u) ? (x - b) * sc * 254.0f : 0.0f; }
__device__ __forceinline__ float ulp254(float b) { const unsigned E = (__float_as_uint(b) >> 23) & 255u; return E >= 16u ? __uint_as_float((E - 7u) << 23) * (1.0f / 254.0f) : 0.0f; }
__device__ __forceinline__ unsigned pk2_q12(float a, float b) {
    const int ia = (int)__builtin_rintf(__builtin_amdgcn_fmed3f(a * 4096.0f, -32767.f, 32767.f)), ib = (int)__builtin_rintf(__builtin_amdgcn_fmed3f(b * 4096.0f, -32767.f, 32767.f));
    return (unsigned)(ia & 0xFFFF) | ((unsigned)ib << 16); }
__device__ __forceinline__ float q12_lo(unsigned w) { return (float)((int)(w << 16) >> 16) * (1.0f / 4096.0f); }
__device__ __forceinline__ float q12_hi(unsigned w) { return (float)((int)w >> 16) * (1.0f / 4096.0f); }
__device__ __forceinline__ float sb(unsigned w, int i) { return (float)((int)(w << (24 - 8 * i)) >> 24); }
struct PairDesc { const float* W; bf16* WT; int K, N, k0, n0, mode; };
template <bool NT>
__device__ __forceinline__ void pair_load(const PairDesc& p, f32x4 (&v)[16], int lane) {
    const float* src = p.W + (size_t)(p.k0 + (lane >> 3)) * p.N + p.n0 + (lane & 7) * 4;
#pragma unroll
    for (int i = 0; i < 16; ++i) { const f32x4* q = (const f32x4*)(src + (size_t)(8 * (i & 7)) * p.N + 32 * (i >> 3)); v[i] = NT ? __builtin_nontemporal_load(q) : *q; }
}
__device__ __forceinline__ void pair_store(const PairDesc& p, const f32x4 (&v)[16], LAS float* scr, int lane) {
#pragma unroll
    for (int hh = 0; hh < 2; ++hh) {
        const int drow0 = drow_of(p.n0 + 32 * hh, p.mode);
#pragma unroll
        for (int i = 0; i < 8; ++i) { LAS float* d = scr + (8 * i + (lane >> 3)) * 33 + (lane & 7) * 4; const f32x4 x = v[8 * hh + i]; d[0] = x.x; d[1] = x.y; d[2] = x.z; d[3] = x.w; }
        LDS_WAIT(); asm volatile("" ::: "memory");
        const int c = lane & 7;
#pragma unroll
        for (int j = 0; j < 4; ++j) { const int n = (lane >> 3) + 8 * j; const LAS float* s = scr + (8 * c) * 33 + n;
            if (p.mode >= 3 || (p.mode == 2 && p.k0 < KQ)) { const float q8 = p.mode == 5 ? WAU8_SCALE : W8_SCALE; const size_t pitchb = p.mode == 2 ? (size_t)p.K * 2 : (size_t)p.K; v2u o; o.x = pk4_fp8(s[0 * 33] * q8, s[1 * 33] * q8, s[2 * 33] * q8, s[3 * 33] * q8); o.y = pk4_fp8(s[4 * 33] * q8, s[5 * 33] * q8, s[6 * 33] * q8, s[7 * 33] * q8);
                *(v2u*)((unsigned char*)p.WT + (size_t)(drow0 + n) * pitchb + p.k0 + 8 * c) = o; }
            else { v4u o; o.x = pk2(s[0 * 33], s[1 * 33]); o.y = pk2(s[2 * 33], s[3 * 33]); o.z = pk2(s[4 * 33], s[5 * 33]); o.w = pk2(s[6 * 33], s[7 * 33]);
                *(v4u*)(p.WT + (size_t)(drow0 + n) * p.K + p.k0 + 8 * c) = o; } }
        LDS_WAIT(); asm volatile("" ::: "memory");
    }
}
template <class Src, bool NT>
__device__ __forceinline__ void run_pairs(Src& S, LAS float* scr, int lane) {
    PairDesc a, b; f32x4 va[16], vb[16];
    if (!S.next(a)) return;
    pair_load<NT>(a, va, lane);
    for (;;) {
        const bool hb = S.next(b); if (hb) pair_load<NT>(b, vb, lane);
        pair_store(a, va, scr, lane);
        if (!hb) break;
        const bool ha = S.next(a); if (ha) pair_load<NT>(a, va, lane);
        pair_store(b, vb, scr, lane);
        if (!ha) break;
    }
}
struct QueueSrc {
    gu32* head; const float* W; bf16* WT; int K, N, mode, lane, left;
    __device__ __forceinline__ bool next(PairDesc& p) {
        if (left-- <= 0) return false;
        unsigned it = 0; if (lane == 0) it = __hip_atomic_fetch_add(head, 1u, __ATOMIC_RELAXED, __HIP_MEMORY_SCOPE_AGENT);
        it = (unsigned)__builtin_amdgcn_readfirstlane((int)it);
        const int npb = N / 64; if (it >= (unsigned)((K / 64) * npb)) return false;
        p.W = W; p.WT = WT; p.K = K; p.N = N; p.mode = mode; p.k0 = 64 * ((int)it / npb); p.n0 = 64 * ((int)it % npb); return true; }
};
struct P0Src {
    int it, stride; const float *w_in, *w_au, *w_pu, *w_pg, *w_out, *w_ffi; bf16 *WIN, *WAU, *WPG, *WOUT, *WFFI; unsigned char *WG8, *W8P, *W8AU; int pend_k0, pend_n0;
    __device__ __forceinline__ bool next(PairDesc& p) {
        if (pend_k0 >= 0) { p.W = w_in; p.WT = (bf16*)WG8; p.K = D; p.N = INW; p.mode = 3; p.k0 = pend_k0; p.n0 = pend_n0; pend_k0 = -1; return true; }
        constexpr int P_IN = (D / 64) * (2048 / 64), P_P8 = (D / 64) * (4608 / 64), P_G8 = (D / 128) * (8192 / 64), P_AU = (AW / 64) * (D / 64), P_PU = P_AU, P_OUT = (D / 64) * (D / 64);
        constexpr int P_FFI = (D / 64) * (2 * FF / 64);
        constexpr int NPAIRS = P_IN + P_P8 + P_G8 + P_AU + P_PU + P_OUT + P_FFI;
        if (it >= NPAIRS) return false;
        int r = it; it += stride; int pair; int npb = 0, nbase = 0;
        if (r < P_IN) { p.W = w_in; p.WT = WIN; p.K = D; p.N = INW; p.mode = 0; pair = r; npb = 2048 / 64; nbase = 2560; }
        else if ((r -= P_IN) < P_P8) { p.W = w_in; p.WT = (bf16*)W8P; p.K = D; p.N = INW; p.mode = 4; pair = r; npb = 4608 / 64; }
        else if ((r -= P_P8) < P_G8) {
            p.W = w_in; p.WT = (bf16*)WG8; p.K = D; p.N = INW; p.mode = 3; p.k0 = 128 * (r / 128); p.n0 = 4608 + 64 * (r % 128); pend_k0 = p.k0 + 64; pend_n0 = p.n0; return true; }
        else if ((r -= P_G8) < P_AU) { p.W = w_au; p.WT = (bf16*)W8AU; p.K = 2 * AW; p.N = D; p.mode = 5; pair = r; }
        else if ((r -= P_AU) < P_PU) { p.W = w_pu; p.WT = WAU + AW; p.K = D; p.N = D; p.mode = 0; pair = r; }
        else if ((r -= P_PU) < P_OUT) { p.W = w_out; p.WT = WOUT; p.K = D; p.N = D; p.mode = 0; pair = r; }
        else { r -= P_OUT; p.W = w_ffi; p.WT = WFFI; p.K = D; p.N = 2 * FF; p.mode = 2; pair = r; }
        if (npb == 0) npb = p.N / 64; p.k0 = 64 * (pair / npb); p.n0 = nbase + 64 * (pair % npb); return true; }
};

__device__ __forceinline__ void ln_row(const float* src, bf16* dstb, unsigned char* dst8, unsigned char* dstlo, const float* g, const float* bt, int lane) {
    f32x4 v[16]; float s = 0.f;
#pragma unroll
    for (int j = 0; j < 16; ++j) v[j] = ((const f32x4*)src)[lane + 64 * j];
    f32x4 ga[4], ba[4];
#pragma unroll
    for (int jj = 0; jj < 4; ++jj) { ga[jj] = ((const f32x4*)g)[lane + 64 * jj]; ba[jj] = ((const f32x4*)bt)[lane + 64 * jj]; }
#pragma unroll
    for (int j = 0; j < 16; ++j) s += (v[j].x + v[j].y) + (v[j].z + v[j].w);
    const float mean = wave_sum(s) * (1.f / D); float s2 = 0.f;
#pragma unroll
    for (int j = 0; j < 16; ++j) { v[j] = v[j] - mean; s2 += (v[j].x * v[j].x + v[j].y * v[j].y) + (v[j].z * v[j].z + v[j].w * v[j].w); }
    const float rstd = 1.f / sqrtf(wave_sum(s2) * (1.f / D) + LN_EPS);
#pragma unroll
    for (int k = 0; k < 4; ++k) {
        f32x4 gn[4], bn[4];
        if (k < 3) {
#pragma unroll
            for (int jj = 0; jj < 4; ++jj) { gn[jj] = ((const f32x4*)g)[lane + 64 * (4 * k + 4 + jj)]; bn[jj] = ((const f32x4*)bt)[lane + 64 * (4 * k + 4 + jj)]; } }
#pragma unroll
        for (int jj = 0; jj < 4; ++jj) { const int j = 4 * k + jj;
            const f32x4 y = v[j] * rstd * ga[jj] + ba[jj];
            v2u w; w.x = pk2(y.x, y.y); w.y = pk2(y.z, y.w); ((v2u*)dstb)[lane + 64 * j] = w;
            ((unsigned*)dst8)[lane + 64 * j] = pk4_fp8(y.x * H8_SCALE, y.y * H8_SCALE, y.z * H8_SCALE, y.w * H8_SCALE);
            ((unsigned*)dstlo)[lane + 64 * j] = pk4_fp8(lo_of(y.x, pg8::bf_lo(w.x)), lo_of(y.y, pg8::bf_hi(w.x)), lo_of(y.z, pg8::bf_lo(w.y)), lo_of(y.w, pg8::bf_hi(w.y))); }
        if (k < 3) {
#pragma unroll
            for (int jj = 0; jj < 4; ++jj) { ga[jj] = gn[jj]; ba[jj] = bn[jj]; } }
    }
}

__device__ __forceinline__ void sincos_d(float af, float& sn, float& cs) {
    const double a = (double)af;
    const double q = __builtin_rint(a * 0.63661977236758134308);
    const double r = (a - q * 1.57079632679489655800) - q * 6.12323399573676603587e-17;
    const double r2 = r * r;
    double sp = r * (1.0 + r2 * (-1.66666666666666657415e-01 + r2 * (8.33333333333309497557e-03 + r2 * (-1.98412698412589187999e-04 + r2 * (2.75573192104428224777e-06 + r2 * (-2.50519113340291937613e-08 + r2 * 1.58969099521155010221e-10))))));
    double cp = 1.0 + r2 * (-0.5 + r2 * (4.16666666666666019037e-02 + r2 * (-1.38888888888741095749e-03 + r2 * (2.48015872894767294178e-05 + r2 * (-2.75573143513906633035e-07 + r2 * (2.08757232129817482790e-09 + r2 * -1.13596475577881948265e-11))))));
    const int qi = (int)q & 3;
    const double s_ = (qi & 1) ? cp : sp, c_ = (qi & 1) ? sp : cp;
    sn = (float)((qi & 2) ? -s_ : s_);
    cs = (float)(((qi + 1) & 2) ? -c_ : c_);
}

typedef float f32x16 __attribute__((ext_vector_type(16)));
typedef short s16x4 __attribute__((ext_vector_type(4)));
__device__ __forceinline__ s16x4 vtr(const LAS unsigned char* p) { return __builtin_bit_cast(s16x4, __builtin_amdgcn_ds_read_tr16_b64_v4i16((LAS s16x4*)p)); }

__device__ __forceinline__ void acc8(float (&a)[8], const v4u& w) {
    a[0] += pg8::bf_lo(w.x); a[1] += pg8::bf_hi(w.x); a[2] += pg8::bf_lo(w.y); a[3] += pg8::bf_hi(w.y); a[4] += pg8::bf_lo(w.z); a[5] += pg8::bf_hi(w.z); a[6] += pg8::bf_lo(w.w); a[7] += pg8::bf_hi(w.w); }
template <int W>
__device__ __forceinline__ void pool_task(const bf16* UB, bf16* POOLED, int b, int run, int g, int lane) {
    const int t0 = run * 32; const size_t coff = (size_t)g * 512 + 8 * lane;
    v4u win[W - 1 + 8];
#pragma unroll
    for (int j = 0; j < W - 1; ++j) { const int tt = t0 - (W - 1) + j; const int srow = tt >= 0 ? b * SEQ + tt : M + NMETA + tt; win[j] = *(const v4u*)(UB + (size_t)srow * PW + coff); }
#pragma unroll 1
    for (int blk = 0; blk < 4; ++blk) {
        const int tb = t0 + 8 * blk;
#pragma unroll
        for (int o = 0; o < 8; ++o) win[W - 1 + o] = *(const v4u*)(UB + (size_t)(b * SEQ + tb + o) * PW + coff);
#pragma unroll
        for (int o = 0; o < 8; ++o) {
            float a[8];
#pragma unroll
            for (int e = 0; e < 8; ++e) a[e] = 0.f;
#pragma unroll
            for (int i = 0; i < W; ++i) acc8(a, win[W - 1 + o - i]);
            float s[8];
#pragma unroll
            for (int e = 0; e < 8; ++e) s[e] = 0.f;
            acc8(s, win[W - 1 + o]);
            const float rw = 1.0f / (float)W; v4u ow;
            ow.x = pk2(a[0] * rw - s[0], a[1] * rw - s[1]); ow.y = pk2(a[2] * rw - s[2], a[3] * rw - s[3]);
            ow.z = pk2(a[4] * rw - s[4], a[5] * rw - s[5]); ow.w = pk2(a[6] * rw - s[6], a[7] * rw - s[7]);
            *(v4u*)(POOLED + (size_t)(b * SEQ + tb + o) * PW + coff) = ow;
        }
#pragma unroll
        for (int j = 0; j < W - 1; ++j) win[j] = win[j + 8];
    }
}

struct SchedBase { int G, c; };
struct SchedF8 : SchedBase {
    const unsigned char *A, *BP;
    __device__ __forceinline__ bool next(int i, pg8::Unit& u) const {
        const int L = i * G + c; if (L >= 650) return false;
        if (L < 640) pg8::tile_of(L, 64, 10, u.pm, u.pn); else { u.pm = 64; u.pn = 8 + (L - 640); }
        u.z = 1; return true; }
    __device__ __forceinline__ void ptrs(const pg8::Unit& u, const char*& a, const char*& b) const { a = (const char*)A + (size_t)u.pm * 256 * D; b = (const char*)BP + (size_t)u.pn * 256 * D; }
};
struct SchedProj : SchedBase {
    const bf16* A; const bf16* Bt;
    __device__ __forceinline__ bool next(int i, pg8::Unit& u) const {
        const int L = i * G + c; if (L >= 512) return false;
        pg8::tile_of(L, 64, 8, u.pm, u.pn); u.pn += 10; u.z = 0; return true; }
    __device__ __forceinline__ void ptrs(const pg8::Unit& u, const char*& a, const char*& b) const { a = (const char*)A + (size_t)u.pm * 256 * D * 2; b = (const char*)Bt + (size_t)u.pn * 256 * D * 2; }
};
struct SchedPlain : SchedBase {
    const bf16* A; const bf16* Bt; int nM, nN, K, wgm;
    __device__ __forceinline__ bool next(int i, pg8::Unit& u) const { const int L = i * G + c; if (L >= nM * nN) return false; pg8::tile_of(L, nM, nN, u.pm, u.pn, wgm); u.z = 0; return true; }
    __device__ __forceinline__ void ptrs(const pg8::Unit& u, const char*& a, const char*& b) const { a = (const char*)A + (size_t)u.pm * 256 * K * 2; b = (const char*)Bt + (size_t)u.pn * 256 * K * 2; }
};
struct SchedXLN : SchedBase {
    const bf16* A; const bf16* Bt; int K;
    __device__ __forceinline__ bool next(int i, pg8::Unit& u) const { if (i >= 4) return false; const int x = c & 7, sl = c >> 3; u.pm = 4 * (4 * i + (x >> 1)) + (sl & 3); u.pn = 8 * (x & 1) + (sl >> 2); u.z = 0; return true; }
    __device__ __forceinline__ void ptrs(const pg8::Unit& u, const char*& a, const char*& b) const { a = (const char*)A + (size_t)u.pm * 256 * K * 2; b = (const char*)Bt + (size_t)u.pn * 256 * K * 2; }
};
struct SchedFFN : SchedBase {
    static constexpr int NT0 = KQ / 128;
    const char *AQ, *A, *Bt;
    __device__ __forceinline__ bool next(int i, pg8::Unit& u) const { const int L = i * G + c; if (L >= 64 * 86) return false; pg8::tile_of(L, 64, 86, u.pm, u.pn, 8); u.z = 0; return true; }
    __device__ __forceinline__ void ptrs(const pg8::Unit& u, const char*& a, const char*& b) const { a = AQ + (size_t)u.pm * 256 * D * 2; b = Bt + (size_t)u.pn * 256 * D * 2; }
    __device__ __forceinline__ void ptrs2(const pg8::Unit& u, const char*& a, const char*& b) const { a = A + (size_t)u.pm * 256 * D * 2 + KQ * 2; b = Bt + (size_t)u.pn * 256 * D * 2 + KQ * 2; }
};
struct SchedPitch : SchedBase {
    const char* A; const char* Bt; int nM, nN; size_t pa, pb; int wgm;
    __device__ __forceinline__ bool next(int i, pg8::Unit& u) const { const int L = i * G + c; if (L >= nM * nN) return false; pg8::tile_of(L, nM, nN, u.pm, u.pn, wgm); u.z = 0; return true; }
    __device__ __forceinline__ void ptrs(const pg8::Unit& u, const char*& a, const char*& b) const { a = A + (size_t)u.pm * pa; b = Bt + (size_t)u.pn * pb; }
};
struct SchedMix : SchedBase {
    const char *AG, *BG, *A0, *B0, *A1, *B1;
    __device__ __forceinline__ bool next(int i, pg8::Unit& u) const { const int L = i * G + c; if (L >= 64 * 16) return false; pg8::tile_of(L, 64, 16, u.pm, u.pn, 8); u.z = 0; return true; }
    __device__ __forceinline__ void ptrs(const pg8::Unit& u, const char*& a, const char*& b) const { a = AG + ((size_t)u.pm << 20); b = BG + ((size_t)(2 * u.pn) << 20); }
    __device__ __forceinline__ void ptrs_all(const pg8::Unit& u, const char*& g2b, const char*& fa, const char*& fb, const char*& ma, const char*& mb) const {
        g2b = BG + ((size_t)(2 * u.pn + 1) << 20); fa = A0 + ((size_t)u.pm << 20); fb = B0 + ((size_t)u.pn << 20); ma = A1 + ((size_t)u.pm << 20); mb = B1 + ((size_t)u.pn << 20); }
};
struct SchedFold : SchedBase {
    const bf16* A; const bf16* Bt;
    __device__ __forceinline__ bool next(int i, pg8::Unit& u) const { const int L = i * G + c; if (L >= 16 * 8) return false; u.pm = L & 15; u.pn = L >> 4; u.z = 0; return true; }
    __device__ __forceinline__ void ptrs(const pg8::Unit& u, const char*& a, const char*& b) const { a = (const char*)A + ((size_t)u.pm * 256 * D + (size_t)(u.pn >> 1) * 512) * 2; b = (const char*)Bt + (size_t)u.pn * 256 * 512 * 2; }
};

using pg8::f32x4; using pg8::u32x4;
__device__ __forceinline__ f32x4 i2f(const pg8::f32x4& v) { return __builtin_convertvector(__builtin_bit_cast(pg8::i32x4, v), pg8::f32x4); }
__device__ __forceinline__ u32x4 pack8(const pg8::f32x4& v0, const pg8::f32x4& v1) { u32x4 w; w.x = pg8::cvt_pk_bf16(v0[0], v0[1]); w.y = pg8::cvt_pk_bf16(v0[2], v0[3]); w.z = pg8::cvt_pk_bf16(v1[0], v1[1]); w.w = pg8::cvt_pk_bf16(v1[2], v1[3]); return w; }

template <bool INT>
struct EpiProj {
    static constexpr bool HAS_MID = false, PERM = true;
    bf16 *Q, *Kb, *Vb, *U; const float* rope; float unscale;
    __device__ __forceinline__ void operator()(const f32x4 (&acc)[2][2][4][2], const pg8::Unit& u, int wr, int wc, int fr, int fq) const {
        const int rbase = u.pm * 256 + wr * 64 + fr; const int pn = u.pn;
        if (pn >= 9) {
            bf16* base; int ldc, col0;
            if (pn == 9) { base = Vb; ldc = KVW; col0 = wc * 32 + 8 * fq; } else { base = U; ldc = PW; col0 = (pn - 10) * 256 + wc * 32 + 8 * fq; }
#pragma unroll
            for (int ai = 0; ai < 2; ++ai)
#pragma unroll
                for (int m = 0; m < 4; ++m) { bf16* rowp = base + (size_t)(rbase + ai * 128 + m * 16) * ldc + col0;
#pragma unroll
                    for (int bj = 0; bj < 2; ++bj) *(u32x4*)(rowp + bj * 128) = pack8((INT ? i2f(acc[ai][bj][m][0]) : acc[ai][bj][m][0]) * unscale, (INT ? i2f(acc[ai][bj][m][1]) : acc[ai][bj][m][1]) * unscale); }
        } else {
            bf16* base; int ldc, col0; float sc;
            if (pn < 8) { base = Q; ldc = AW; col0 = pn * 256 + wc * 32 + 8 * fq; sc = 0.125f; } else { base = Kb; ldc = KVW; col0 = wc * 32 + 8 * fq; sc = 1.0f; }
            const float us = unscale;
            const bool ropew = (wc & 1) == 0;
            const float sgn = (fq == 0) ? -1.0f : 1.0f;
#pragma unroll
            for (int ai = 0; ai < 2; ++ai)
#pragma unroll
                for (int m = 0; m < 4; ++m) { const int row = rbase + ai * 128 + m * 16; bf16* rowp = base + (size_t)row * ldc + col0;
                    f32x4 c0, c1, s0, s1;
                    if (ropew) { const int pos = row < M ? (row & (SEQ - 1)) + NMETA : row - M; const float* rp = rope + (size_t)pos * 16;
                        c0 = *(const f32x4*)(rp); c1 = *(const f32x4*)(rp + 4); s0 = *(const f32x4*)(rp + 8) * sgn; s1 = *(const f32x4*)(rp + 12) * sgn; }
#pragma unroll
                    for (int bj = 0; bj < 2; ++bj) { f32x4 v0 = (INT ? i2f(acc[ai][bj][m][0]) : acc[ai][bj][m][0]) * us, v1 = (INT ? i2f(acc[ai][bj][m][1]) : acc[ai][bj][m][1]) * us;
                        if (ropew) { f32x4 p0, p1;
#pragma unroll
                            for (int e = 0; e < 4; ++e) { p0[e] = __shfl_xor(v0[e], 16); p1[e] = __shfl_xor(v1[e], 16); }
                            const f32x4 r0 = v0 * c0 + p0 * s0, r1 = v1 * c1 + p1 * s1;
                            if (fq < 2) { v0 = r0; v1 = r1; } }
                        v0 = v0 * sc; v1 = v1 * sc;
                        *(u32x4*)(rowp + bj * 128) = pack8(v0, v1); } }
        }
    }
};
struct EpiFold {
    static constexpr bool HAS_MID = false, PERM = true;
    bf16* O;
    __device__ __forceinline__ void operator()(const f32x4 (&acc)[2][2][4][2], const pg8::Unit& u, int wr, int wc, int fr, int fq) const {
        const int row0 = u.pm * 256 + wr * 64 + fr, col0 = u.pn * 256 + wc * 32 + 8 * fq;
#pragma unroll
        for (int ai = 0; ai < 2; ++ai)
#pragma unroll
            for (int m = 0; m < 4; ++m) { bf16* rowp = O + (size_t)(row0 + ai * 128 + m * 16) * PW + col0;
#pragma unroll
                for (int bj = 0; bj < 2; ++bj) *(u32x4*)(rowp + bj * 128) = pack8(acc[ai][bj][m][0], acc[ai][bj][m][1]); }
    }
};
__device__ __forceinline__ void mul8(f32x4& v0, f32x4& v1, const u32x4& gw) {
    v0[0] *= pg8::bf_lo(gw.x); v0[1] *= pg8::bf_hi(gw.x); v0[2] *= pg8::bf_lo(gw.y); v0[3] *= pg8::bf_hi(gw.y);
    v1[0] *= pg8::bf_lo(gw.z); v1[1] *= pg8::bf_hi(gw.z); v1[2] *= pg8::bf_lo(gw.w); v1[3] *= pg8::bf_hi(gw.w); }
struct EpiMixF {
    static constexpr bool HAS_MID = true, PERM = true; static constexpr int NST = 16;
    const float* bgate; u32x4* slab; bf16* MIXED;
    __device__ __forceinline__ void gate(const f32x4 (&acc)[2][2][4][2], const pg8::Unit& u, int j, int wr, int wc, int fr, int fq) const {
        asm volatile("" : "+v"(fr), "+v"(fq));
        const int ch0 = (2 * u.pn + j) * 128 + wc * 32 + 8 * fq;
        u32x4* sl = slab + (wr * 4 + wc) * 64 + fq * 16 + fr;
        f32x4 bA[2], bB[2];
#pragma unroll
        for (int n = 0; n < 2; ++n) { bA[n] = *(const f32x4*)(bgate + ch0 + 4 * n); bB[n] = *(const f32x4*)(bgate + D + ch0 + 4 * n); }
#pragma unroll
        for (int ai = 0; ai < 2; ++ai)
#pragma unroll
            for (int m = 0; m < 4; ++m) {
                f32x4 a0 = i2f(acc[ai][0][m][0]) * G8_UNSCALE + bA[0], a1 = i2f(acc[ai][0][m][1]) * G8_UNSCALE + bA[1], b0 = i2f(acc[ai][1][m][0]) * G8_UNSCALE + bB[0], b1 = i2f(acc[ai][1][m][1]) * G8_UNSCALE + bB[1];
#pragma unroll
                for (int e = 0; e < 4; ++e) {
                    const float xa0 = __builtin_amdgcn_fmed3f(a0[e], -30.f, 30.f), xb0 = __builtin_amdgcn_fmed3f(b0[e], -30.f, 30.f), xa1 = __builtin_amdgcn_fmed3f(a1[e], -30.f, 30.f), xb1 = __builtin_amdgcn_fmed3f(b1[e], -30.f, 30.f);
                    const float ea0 = 1.0f + __builtin_amdgcn_exp2f(-1.44269504f * xa0), eb0 = 1.0f + __builtin_amdgcn_exp2f(-1.44269504f * xb0);
                    const float ea1 = 1.0f + __builtin_amdgcn_exp2f(-1.44269504f * xa1), eb1 = 1.0f + __builtin_amdgcn_exp2f(-1.44269504f * xb1);
                    a0[e] = eb0 * __builtin_amdgcn_rcpf(ea0); b0[e] = __builtin_amdgcn_rcpf(eb0); a1[e] = eb1 * __builtin_amdgcn_rcpf(ea1); b1[e] = __builtin_amdgcn_rcpf(eb1); }
                sl[((j * 2 + 0) * 8 + ai * 4 + m) * 512] = pack8(a0, a1); sl[((j * 2 + 1) * 8 + ai * 4 + m) * 512] = pack8(b0, b1); }
    }
    __device__ __forceinline__ void mid(f32x4 (&acc)[2][2][4][2], const pg8::Unit& u, int wr, int wc, int fr, int fq) const {
        asm volatile("" : "+v"(fr), "+v"(fq));
        const u32x4* sl = slab + (wr * 4 + wc) * 64 + fq * 16 + fr;
#pragma unroll
        for (int ai = 0; ai < 2; ++ai)
#pragma unroll
            for (int m = 0; m < 4; ++m)
#pragma unroll
                for (int bj = 0; bj < 2; ++bj) { const u32x4 gw = sl[((bj * 2 + 0) * 8 + ai * 4 + m) * 512];
                    f32x4 v0 = i2f(acc[ai][bj][m][0]) * AU8_UNSCALE, v1 = i2f(acc[ai][bj][m][1]) * AU8_UNSCALE; mul8(v0, v1, gw);
                    acc[ai][bj][m][0] = v0; acc[ai][bj][m][1] = v1; }
    }
    __device__ __forceinline__ void operator()(const f32x4 (&acc)[2][2][4][2], const pg8::Unit& u, int wr, int wc, int fr, int fq) const {
        asm volatile("" : "+v"(fr), "+v"(fq));
        const int row0 = u.pm * 256 + wr * 64 + fr, col0 = u.pn * 256 + wc * 32 + 8 * fq;
        const u32x4* sl = slab + (wr * 4 + wc) * 64 + fq * 16 + fr;
        u32x4 gwv[2][4][2];
#pragma unroll
        for (int ai = 0; ai < 2; ++ai)
#pragma unroll
            for (int m = 0; m < 4; ++m)
#pragma unroll
                for (int bj = 0; bj < 2; ++bj) gwv[ai][m][bj] = sl[((bj * 2 + 1) * 8 + ai * 4 + m) * 512];
#pragma unroll
        for (int ai = 0; ai < 2; ++ai)
#pragma unroll
            for (int m = 0; m < 4; ++m) { const size_t off = (size_t)(row0 + ai * 128 + m * 16) * D + col0;
#pragma unroll
                for (int bj = 0; bj < 2; ++bj) {
                    f32x4 v0 = acc[ai][bj][m][0], v1 = acc[ai][bj][m][1]; mul8(v0, v1, gwv[ai][m][bj]);
                    *(u32x4*)(MIXED + off + bj * 128) = pack8(v0, v1); } }
    }
};
template <bool OUTF>
struct EpiResidXLN {
    static constexpr bool HAS_MID = false, PERM = true;
    const bf16* Xb; const unsigned char* Xlo; int lo_pitch, lo_off;
    unsigned long long* xs; gu32* cnt; gu32* tmo; LAS unsigned char* lt;
    float* outf; bf16* outb; const float* g2; const float* b2; unsigned char* outq;
    __device__ __forceinline__ void operator()(f32x4 (&v)[2][2][4][2], const pg8::Unit& u, int wr, int wc, int fr, int fq) const {
        asm volatile("" : "+v"(fr), "+v"(fq));
        typedef float f32x2v __attribute__((ext_vector_type(2)));
        LAS f32x2v* P = (LAS f32x2v*)lt;
        LAS f32x2v* S = (LAS f32x2v*)(lt + 8192);
        LAS unsigned* flag = (LAS unsigned*)(lt + 8192 + 2048);
        const int lane = fq * 16 + fr, wid = wr * 4 + wc;
        const int row0 = u.pm * 256 + wr * 64 + fr, col0 = u.pn * 256 + wc * 32 + 8 * fq;
        {
#pragma unroll
            for (int ai = 0; ai < 2; ++ai)
#pragma unroll
                for (int m = 0; m < 4; ++m) { const size_t off = (size_t)(row0 + ai * 128 + m * 16) * D + col0;
#pragma unroll
                    for (int bj = 0; bj < 2; ++bj) { const u32x4 xw = *(const u32x4*)(Xb + off + bj * 128);
                        f32x4 r0, r1;
                        if constexpr (OUTF) { r0[0] = q12_lo(xw.x); r0[1] = q12_hi(xw.x); r0[2] = q12_lo(xw.y); r0[3] = q12_hi(xw.y); r1[0] = q12_lo(xw.z); r1[1] = q12_hi(xw.z); r1[2] = q12_lo(xw.w); r1[3] = q12_hi(xw.w); }
                        else { r0[0] = pg8::bf_lo(xw.x); r0[1] = pg8::bf_hi(xw.x); r0[2] = pg8::bf_lo(xw.y); r0[3] = pg8::bf_hi(xw.y); r1[0] = pg8::bf_lo(xw.z); r1[1] = pg8::bf_hi(xw.z); r1[2] = pg8::bf_lo(xw.w); r1[3] = pg8::bf_hi(xw.w);
                            const v2u lw = *(const v2u*)(Xlo + (size_t)(row0 + ai * 128 + m * 16) * lo_pitch + lo_off + col0 + bj * 128);
#pragma unroll
                            for (int e = 0; e < 4; ++e) { r0[e] += sb(lw.x, e) * ulp254(r0[e]); r1[e] += sb(lw.y, e) * ulp254(r1[e]); } }
                        v[ai][bj][m][0] = r0 * DN_ALPHA + v[ai][bj][m][0]; v[ai][bj][m][1] = r1 * DN_ALPHA + v[ai][bj][m][1]; }
                    asm volatile("" : "+v"(v[ai][0][m][0]), "+v"(v[ai][0][m][1]), "+v"(v[ai][1][m][0]), "+v"(v[ai][1][m][1]));
                    if (m == 3) asm volatile("" ::: "memory"); }
        }
#pragma unroll
        for (int ai = 0; ai < 2; ++ai)
#pragma unroll
            for (int m = 0; m < 4; ++m) {
                float s = 0.f;
#pragma unroll
                for (int bj = 0; bj < 2; ++bj)
#pragma unroll
                    for (int n = 0; n < 2; ++n) { const f32x4 x = v[ai][bj][m][n]; s += (x[0] + x[1]) + (x[2] + x[3]); }
                s += __shfl_xor(s, 16); s += __shfl_xor(s, 32);
                const float mw = s * (1.0f / 64.0f); float q = 0.f;
#pragma unroll
                for (int bj = 0; bj < 2; ++bj)
#pragma unroll
                    for (int n = 0; n < 2; ++n) { const f32x4 d = v[ai][bj][m][n] - mw; q += (d[0] * d[0] + d[1] * d[1]) + (d[2] * d[2] + d[3] * d[3]); }
                q += __shfl_xor(q, 16); q += __shfl_xor(q, 32);
                if (fq == 0) P[(ai * 128 + wr * 64 + m * 16 + fr) * 4 + wc] = (f32x2v){mw, q};
            }
        asm volatile("s_waitcnt lgkmcnt(0)" ::: "memory"); __builtin_amdgcn_s_barrier(); asm volatile("" ::: "memory");
        const int row = wid * 32 + (lane & 31);
        if (lane < 32) {
            const f32x2v a = P[row * 4 + 0], bq = P[row * 4 + 1], c = P[row * 4 + 2], d = P[row * 4 + 3];
            const float mt = (a.x + bq.x + c.x + d.x) * 0.25f;
            const float da = a.x - mt, db = bq.x - mt, dc = c.x - mt, dd = d.x - mt;
            const float m2 = (a.y + bq.y) + (c.y + d.y) + 64.0f * ((da * da + db * db) + (dc * dc + dd * dd));
            unsigned long long* slot = xs + ((size_t)(u.pm * 256 + row) * 16 + u.pn);
            __hip_atomic_store(slot, ((unsigned long long)__float_as_uint(m2) << 32) | __float_as_uint(mt), __ATOMIC_RELAXED, __HIP_MEMORY_SCOPE_AGENT);
        }
        asm volatile("s_waitcnt vmcnt(0)" ::: "memory");
        gu32* cw = cnt + 64 * u.pm;
        if (lane == 0) __hip_atomic_fetch_add(cw, 1u, __ATOMIC_RELAXED, __HIP_MEMORY_SCOPE_AGENT);
        if (wid == 0) {
            bool dead = false; unsigned sp = 0;
            while ((unsigned)__builtin_amdgcn_readfirstlane((int)__hip_atomic_load(cw, __ATOMIC_RELAXED, __HIP_MEMORY_SCOPE_AGENT)) < 128u) {
                __builtin_amdgcn_s_sleep(1);
                if ((++sp & 255u) == 0u) { if (__builtin_amdgcn_readfirstlane((int)__hip_atomic_load(tmo, __ATOMIC_RELAXED, __HIP_MEMORY_SCOPE_AGENT))) { dead = true; break; }
                    if (sp > (1u << 20)) { if (lane == 0) __hip_atomic_store(tmo, 1u, __ATOMIC_RELAXED, __HIP_MEMORY_SCOPE_AGENT); dead = true; break; } } }
            __builtin_amdgcn_fence(__ATOMIC_ACQUIRE, "agent");
            if (lane == 0) flag[0] = dead ? 1u : 0u;
        }
        asm volatile("s_waitcnt vmcnt(0) lgkmcnt(0)" ::: "memory"); __builtin_amdgcn_s_barrier(); asm volatile("" ::: "memory");
        const bool bad = flag[0] != 0u;
        if (lane < 32) {
            const unsigned long long* slot = xs + (size_t)(u.pm * 256 + row) * 16; float mt[16], m2[16]; float ms = 0.f;
#pragma unroll
            for (int t = 0; t < 16; ++t) { const unsigned long long w = __hip_atomic_load(slot + t, __ATOMIC_RELAXED, __HIP_MEMORY_SCOPE_AGENT); mt[t] = __uint_as_float((unsigned)w); m2[t] = __uint_as_float((unsigned)(w >> 32)); ms += mt[t]; }
            const float mean = ms * (1.0f / 16.0f); float q = 0.f;
#pragma unroll
            for (int t = 0; t < 16; ++t) { const float dm = mt[t] - mean; q += m2[t] + 256.0f * dm * dm; }
            S[row] = (f32x2v){mean, 1.0f / sqrtf(q * (1.0f / (float)D) + LN_EPS)};
        }
        asm volatile("s_waitcnt lgkmcnt(0)" ::: "memory"); __builtin_amdgcn_s_barrier(); asm volatile("" ::: "memory");
        f32x4 g2v[2][2], b2v[2][2];
#pragma unroll
        for (int bj = 0; bj < 2; ++bj)
#pragma unroll
            for (int n = 0; n < 2; ++n) { g2v[bj][n] = *(const f32x4*)(g2 + col0 + bj * 128 + n * 4); b2v[bj][n] = *(const f32x4*)(b2 + col0 + bj * 128 + n * 4); }
        const float qnan = __builtin_nanf("");
#pragma unroll
        for (int ai = 0; ai < 2; ++ai)
#pragma unroll
            for (int m = 0; m < 4; ++m) { const int r = ai * 128 + wr * 64 + m * 16 + fr; f32x2v sr = S[r]; if (bad) sr.y = qnan; const size_t off = (size_t)(u.pm * 256 + r) * D + col0;
#pragma unroll
                for (int bj = 0; bj < 2; ++bj) { const f32x4 o0 = (v[ai][bj][m][0] - sr.x) * sr.y * g2v[bj][0] + b2v[bj][0], o1 = (v[ai][bj][m][1] - sr.x) * sr.y * g2v[bj][1] + b2v[bj][1];
                    if (OUTF) { *(f32x4*)(outf + off + bj * 128) = o0; *(f32x4*)(outf + off + bj * 128 + 4) = o1; }
                    else { u32x4 w; w.x = pk2_q12(o0[0], o0[1]); w.y = pk2_q12(o0[2], o0[3]); w.z = pk2_q12(o1[0], o1[1]); w.w = pk2_q12(o1[2], o1[3]); *(u32x4*)(outb + off + bj * 128) = w;
                        if (u.pn < KQ / 256) { v2u q; q.x = pk4_fp8(o0[0] * H8_SCALE, o0[1] * H8_SCALE, o0[2] * H8_SCALE, o0[3] * H8_SCALE); q.y = pk4_fp8(o1[0] * H8_SCALE, o1[1] * H8_SCALE, o1[2] * H8_SCALE, o1[3] * H8_SCALE);
                            *(v2u*)(outq + (size_t)(u.pm * 256 + r) * (D * 2) + col0 + bj * 128) = q; } } } }
    }
};
template <bool INT>
struct EpiSwiglu {
    static constexpr bool HAS_MID = true, PERM = true;
    bf16* O;
    __device__ __forceinline__ void mid(f32x4 (&acc)[2][2][4][2], const pg8::Unit& u, int wr, int wc, int fr, int fq) const {
#pragma unroll
        for (int ai = 0; ai < 2; ++ai)
#pragma unroll
            for (int bj = 0; bj < 2; ++bj)
#pragma unroll
                for (int m = 0; m < 4; ++m)
#pragma unroll
                    for (int n = 0; n < 2; ++n) acc[ai][bj][m][n] = i2f(acc[ai][bj][m][n]) * G8_UNSCALE;
    }
    __device__ __forceinline__ void operator()(const f32x4 (&acc)[2][2][4][2], const pg8::Unit& u, int wr, int wc, int fr, int fq) const {
        const int row0 = u.pm * 256 + wr * 64 + fr, col0 = u.pn * 128 + wc * 32 + 8 * fq;
#pragma unroll
        for (int ai = 0; ai < 2; ++ai)
#pragma unroll
            for (int m = 0; m < 4; ++m) { f32x4 v0, v1;
                const f32x4 ga = INT ? i2f(acc[ai][0][m][0]) * G8_UNSCALE : acc[ai][0][m][0], gb = INT ? i2f(acc[ai][0][m][1]) * G8_UNSCALE : acc[ai][0][m][1];
                const f32x4 ua = INT ? i2f(acc[ai][1][m][0]) * G8_UNSCALE : acc[ai][1][m][0], ub = INT ? i2f(acc[ai][1][m][1]) * G8_UNSCALE : acc[ai][1][m][1];
#pragma unroll
                for (int e = 0; e < 4; ++e) { v0[e] = ga[e] * pg8::sigmoidf_fast(ga[e]) * ua[e]; v1[e] = gb[e] * pg8::sigmoidf_fast(gb[e]) * ub[e]; }
                *(u32x4*)(O + (size_t)(row0 + ai * 128 + m * 16) * FF + col0) = pack8(v0, v1); }
    }
};

__global__ void __launch_bounds__(NWAVES * 64, 2) fwd_kernel(Args args) {
    extern __shared__ __attribute__((aligned(16))) unsigned char lds[];
    Frame F;
    F.lds = (LAS unsigned char*)lds;
    F.MISC = (volatile LAS unsigned*)(F.lds + MISC_OFF);
    F.tid = threadIdx.x; F.lane = F.tid & 63; F.wave = __builtin_amdgcn_readfirstlane(F.tid >> 6);
    F.G = gridDim.x;
    unsigned char* ws = args.ws;
    F.ctl = (gu32*)(ws + WS_CTL);
    for (int u = F.tid; u < (LDS_BYTES - LDSCTL_OFF) / 4; u += NWAVES * 64) ((LAS unsigned*)(F.lds + LDSCTL_OFF))[u] = 0u;
    __syncthreads();
    XcdBarrier bar = xcd_barrier_post((unsigned*)(F.ctl + CW_BAR), F.MISC + 8);

    const float* x = args.in[0]; const float* meta = args.in[1]; const float* ln_in_g = args.in[2]; const float* ln_in_b = args.in[3];
    const float* w_in = args.in[4]; const float* b_gate = args.in[5]; const float* sinks = args.in[6]; const float* w_attn_up = args.in[7];
    const float* w_pool_grp = args.in[8]; const float* pool_scale = args.in[9]; const float* w_pool_up = args.in[10]; const float* w_out = args.in[11];
    const float* ln1_g = args.in[12]; const float* ln1_b = args.in[13]; const float* w_ffn_in = args.in[14]; const float* w_ffn_down = args.in[15];
    const float* ln2_g = args.in[16]; const float* ln2_b = args.in[17];
    float* out = args.out;
    float* ROPE = (float*)(ws + WS_ROPE);
    bf16 *WIN = (bf16*)(ws + WS_WIN), *WAU = (bf16*)(ws + WS_WAU), *WPG = (bf16*)(ws + WS_WPG), *WOUT = (bf16*)(ws + WS_WOUT), *WFFI = (bf16*)(ws + WS_WFFI), *WFFD = (bf16*)(ws + WS_WFFD);
    unsigned char *H8 = ws + WS_H8, *WG8 = ws + WS_WG8, *W8P = ws + WS_W8P, *ATT8 = ws + WS_ATT8, *W8AU = ws + WS_W8AU;
    bf16 *H = (bf16*)(ws + WS_H), *QB = (bf16*)(ws + WS_Q), *KB = (bf16*)(ws + WS_K), *VB = (bf16*)(ws + WS_V), *UB = (bf16*)(ws + WS_U);
    bf16 *WPT = (bf16*)(ws + WS_WPT), *POOLED = (bf16*)(ws + WS_POOLED), *MIXED = (bf16*)(ws + WS_MIXED), *H1 = (bf16*)(ws + WS_H1), *ACT = (bf16*)(ws + WS_ACT);
    const int gw = blockIdx.x * NWAVES + F.wave, NGW = F.G * NWAVES;

    {
        LAS float* scr = (LAS float*)(F.lds + RING_OFF + F.wave * 16384);
#pragma unroll 1
        for (int pass = 0; pass < 2; ++pass) {
            if (((pass ^ F.wave) & 1) == 0) { P0Src S{gw, NGW, w_in, w_attn_up, w_pool_up, w_pool_grp, w_out, w_ffn_in, WIN, WAU, WPG, WOUT, WFFI, WG8, W8P, W8AU, -1, 0}; run_pairs<P0Src, false>(S, scr, F.lane); }
            else for (int m = gw; m < M; m += NGW) ln_row(x + (size_t)m * D, H + (size_t)m * D, H8 + (size_t)m * D, ws + WS_HLO + (size_t)m * D, ln_in_g, ln_in_b, F.lane);
        }
        for (int m = gw; m < 256; m += NGW) {
            if (m < NMETA) ln_row(meta + (size_t)m * D, H + (size_t)(M + m) * D, H8 + (size_t)(M + m) * D, ws + WS_HLO + (size_t)(M + m) * D, ln_in_g, ln_in_b, F.lane);
            else { v2u z; z.x = 0u; z.y = 0u;
#pragma unroll
                for (int j = 0; j < 16; ++j) { ((v2u*)(H + (size_t)(M + m) * D))[F.lane + 64 * j] = z; ((unsigned*)(H8 + (size_t)(M + m) * D))[F.lane + 64 * j] = 0u; } }
        }
        for (int idx = blockIdx.x * 512 + F.tid; idx < 4 * 512 * 512 / 8; idx += F.G * 512) { const int d0 = (idx & 63) * 8, g = idx >> 15;
            const f32x4 w0 = *(const f32x4*)(w_pool_grp + (size_t)idx * 8), w1 = *(const f32x4*)(w_pool_grp + (size_t)idx * 8 + 4);
            const f32x4 s0 = *(const f32x4*)(pool_scale + g * 512 + d0), s1 = *(const f32x4*)(pool_scale + g * 512 + d0 + 4);
            v4u o; o.x = pk2(w0.x * s0.x, w0.y * s0.y); o.y = pk2(w0.z * s0.z, w0.w * s0.w); o.z = pk2(w1.x * s1.x, w1.y * s1.y); o.w = pk2(w1.z * s1.z, w1.w * s1.w);
            *(v4u*)(WPG + (size_t)idx * 8) = o; }
        for (int idx = blockIdx.x * 512 + F.tid; idx < NPOS * 8; idx += F.G * 512) { const int pos = idx >> 3, i = idx & 7;
            const float invf = __builtin_amdgcn_exp2f(-(float)i * 0.125f * 18.931568569324174f);
            const float ang = (float)pos * invf; float sn, cs; sincos_d(ang, sn, cs);
            ROPE[pos * 16 + i] = cs; ROPE[pos * 16 + 8 + i] = sn; }
    }
    xcd_barrier(bar);

    {
        pg8::Gemm g{D / 2, D / 2, D / 2}; SchedF8 S; S.G = F.G; S.c = (int)blockIdx.x; S.A = H8; S.BP = W8P;
        EpiProj<true> E{QB, KB, VB, UB, ROPE, G8_UNSCALE};
        pg8::gemm_phase<EpiProj<true>, SchedF8, PG8_ALIGN, false, true>(F.lds + RING_OFF, g, S, E);
    }
    {
        pg8::Gemm g{D, D, D}; SchedProj S; S.G = F.G; S.c = (int)blockIdx.x; S.A = H; S.Bt = WIN;
        EpiProj<false> E{QB, KB, VB, UB, ROPE, 1.0f};
        pg8::gemm_phase<EpiProj<false>, SchedProj, PG8_ALIGN, PG8_SP2>(F.lds + RING_OFF, g, S, E);
    }
    {
        pg8::Gemm g{512, D, 512}; SchedFold S; S.G = F.G; S.c = ((int)blockIdx.x + 118) & 255; S.A = WAU + AW; S.Bt = WPG;
        EpiFold E{WPT};
        pg8::gemm_phase<EpiFold, SchedFold, PG8_ALIGN, PG8_SP2>(F.lds + RING_OFF, g, S, E);
    }
    if ((int)blockIdx.x >= 138) {
        QueueSrc Q{F.ctl + CW_Q2, w_ffn_down, WFFD, FF, D, 0, F.lane, 4}; run_pairs<QueueSrc, true>(Q, (LAS float*)(F.lds + RING_OFF + F.wave * 16384), F.lane);
    }
    xcd_barrier(bar);

    {
        LAS unsigned char* Ks = F.lds + RING_OFF; LAS unsigned char* Vs = F.lds + RING_OFF + 224 * 144;
        v4u pk[4], pv[4];
        auto stage_load = [&](int unit) {
            const int tb = unit & 63, kh = (unit >> 6) & 3, b = unit >> 8, t0 = tb * 64;
#pragma unroll
            for (int k = 0; k < 4; ++k) { const int c = F.tid + 512 * k; const int kr = c >> 3, ch = c & 7; int srow = 0; bool ok = c < 224 * 8;
                if (kr < 192) { const int t = t0 - 128 + kr; ok = ok && t >= 0; srow = b * SEQ + t; } else if (kr < 208) srow = M + (kr - 192); else ok = false;
                pk[k] = (v4u){0u, 0u, 0u, 0u}; pv[k] = (v4u){0u, 0u, 0u, 0u};
                if (ok) { pk[k] = *(const v4u*)(KB + (size_t)srow * KVW + kh * 64 + ch * 8); pv[k] = *(const v4u*)(VB + (size_t)srow * KVW + kh * 64 + ch * 8); } } };
        auto stage_store = [&]() {
#pragma unroll
            for (int k = 0; k < 4; ++k) { const int c = F.tid + 512 * k; const int kr = c >> 3, ch = c & 7;
                if (c < 224 * 8) { *(LAS v4u*)(Ks + kr * 144 + ch * 16) = pk[k]; *(LAS v4u*)(Vs + kr * 144 + ch * 16) = pv[k]; } } };
        if ((int)blockIdx.x < 1024) { stage_load(blockIdx.x); stage_store(); }
        __syncthreads();
        for (int unit = blockIdx.x; unit < 1024; unit += F.G) {
            const int tb = unit & 63, kh = (unit >> 6) & 3, b = unit >> 8, t0 = tb * 64;
            const bool has_next = unit + F.G < 1024;
            if (has_next) stage_load(unit + F.G);
            const int hq = kh * 8 + F.wave; const float sink2 = sinks[hq] * 1.44269504f;
            const int r = F.lane & 31, h = F.lane >> 5, g4 = F.lane >> 4, gi = F.lane & 15;
            const int blk_min = t0 < 128 ? ((128 - t0) >> 5) : 0;
            const LAS unsigned char* kbase = Ks + r * 144 + 16 * h;
            const LAS unsigned char* vbase = Vs + (4 * h + (gi >> 2)) * 144 + (16 * (g4 & 1) + 4 * (gi & 3)) * 2;
#pragma unroll 1
            for (int qg = 0; qg < 2; ++qg) {
                const bf16* qrow = QB + (size_t)(b * SEQ + t0 + 32 * qg + r) * AW + hq * 64 + 8 * h;
                pg8::bf16x8 qf[4];
#pragma unroll
                for (int s = 0; s < 4; ++s) qf[s] = *(const pg8::bf16x8*)(qrow + 16 * s);
                f32x16 sc[6];
#pragma unroll
                for (int kb = 0; kb < 6; ++kb) { const int rowbase = kb < 5 ? 32 * (qg + kb) : 192; f32x16 a = {};
#pragma unroll
                    for (int s = 0; s < 4; ++s) { const pg8::bf16x8 kf = *(const LAS pg8::bf16x8*)(kbase + rowbase * 144 + 32 * s); a = __builtin_amdgcn_mfma_f32_32x32x16_bf16(kf, qf[s], a, 0, 0, 0); }
                    sc[kb] = a; }
                float mx = sink2;
                int rr = r - 4 * h; asm volatile("" : "+v"(rr));
#pragma unroll
                for (int kb = 0; kb < 6; ++kb)
#pragma unroll
                    for (int e = 0; e < 16; ++e) { bool valid;
                        const int rk0 = (e & 3) + 8 * (e >> 2);
                        if (kb == 0) valid = rk0 > rr; else if (kb == 4) valid = rk0 <= rr; else if (kb == 5) valid = e < 8  ; else valid = true;
                        if (kb < 5) valid = valid && (qg + kb >= blk_min);
                        const float v = valid ? sc[kb][e] * 1.44269504f : -1e30f; sc[kb][e] = v; mx = fmaxf(mx, v); }
                mx = fmaxf(mx, __shfl_xor(mx, 32));
                float l = 0.f;
#pragma unroll
                for (int kb = 0; kb < 6; ++kb)
#pragma unroll
                    for (int e = 0; e < 16; ++e) { const float p = __builtin_amdgcn_exp2f(sc[kb][e] - mx); sc[kb][e] = p; l += p; }
                l += __shfl_xor(l, 32); l += __builtin_amdgcn_exp2f(sink2 - mx);
                f32x16 o0 = {}, o1 = {};
#pragma unroll
                for (int kb = 0; kb < 6; ++kb) { const int rowbase = kb < 5 ? 32 * (qg + kb) : 192;
#pragma unroll
                    for (int s2 = 0; s2 < 2; ++s2) {
                        pg8::bf16x8 pf; { const unsigned w0 = pg8::cvt_pk_bf16(sc[kb][8 * s2 + 0], sc[kb][8 * s2 + 1]), w1 = pg8::cvt_pk_bf16(sc[kb][8 * s2 + 2], sc[kb][8 * s2 + 3]), w2 = pg8::cvt_pk_bf16(sc[kb][8 * s2 + 4], sc[kb][8 * s2 + 5]), w3 = pg8::cvt_pk_bf16(sc[kb][8 * s2 + 6], sc[kb][8 * s2 + 7]);
                            const u32x4 pw = {w0, w1, w2, w3}; pf = __builtin_bit_cast(pg8::bf16x8, pw); }
                        const LAS unsigned char* vp = vbase + (rowbase + 16 * s2) * 144;
                        const s16x4 a0 = vtr(vp), a1 = vtr(vp + 8 * 144), c0 = vtr(vp + 64), c1 = vtr(vp + 8 * 144 + 64);
                        const pg8::bf16x8 vf0 = {a0[0], a0[1], a0[2], a0[3], a1[0], a1[1], a1[2], a1[3]}, vf1 = {c0[0], c0[1], c0[2], c0[3], c1[0], c1[1], c1[2], c1[3]};
                        o0 = __builtin_amdgcn_mfma_f32_32x32x16_bf16(vf0, pf, o0, 0, 0, 0);
                        o1 = __builtin_amdgcn_mfma_f32_32x32x16_bf16(vf1, pf, o1, 0, 0, 0); } }
                const float inv = 1.0f / l;
                unsigned char* orow = ATT8 + (size_t)(b * SEQ + t0 + 32 * qg + r) * (2 * AW) + hq * 64 + 4 * h;
                const float inv8 = inv * ATT8_SCALE;
#pragma unroll
                for (int rq = 0; rq < 4; ++rq) {
                    *(unsigned*)(orow + 8 * rq) = pk4_fp8(o0[4 * rq + 0] * inv8, o0[4 * rq + 1] * inv8, o0[4 * rq + 2] * inv8, o0[4 * rq + 3] * inv8);
                    *(unsigned*)(orow + 32 + 8 * rq) = pk4_fp8(o1[4 * rq + 0] * inv8, o1[4 * rq + 1] * inv8, o1[4 * rq + 2] * inv8, o1[4 * rq + 3] * inv8); }
            }
            __syncthreads();
            if (has_next) { stage_store(); __syncthreads(); }
        }
        for (int task = gw; task < 2048; task += NGW) { const int g = task & 3, run = (task >> 2) & 127, b = task >> 9;
            if (g == 0) pool_task<2>(UB, POOLED, b, run, 0, F.lane); else if (g == 1) pool_task<4>(UB, POOLED, b, run, 1, F.lane);
            else if (g == 2) pool_task<8>(UB, POOLED, b, run, 2, F.lane); else pool_task<16>(UB, POOLED, b, run, 3, F.lane); }
    }
    xcd_barrier(bar);

    {
        pg8::Gemm g{PW, PW, PW}; SchedMix S; S.G = F.G; S.c = (int)blockIdx.x; S.AG = (const char*)H8; S.BG = (const char*)WG8; S.A0 = (const char*)ATT8; S.B0 = (const char*)W8AU; S.A1 = (const char*)POOLED; S.B1 = (const char*)WPT;
        EpiMixF E{b_gate, (u32x4*)(ws + WS_GSLAB) + (size_t)blockIdx.x * (32 * 512), MIXED};
        pg8::gemm_phase<EpiMixF, SchedMix, PG8_ALIGN, true, false, 1>(F.lds + RING_OFF, g, S, E);
    }
    xcd_barrier(bar);

    {
        pg8::Gemm g{D, D, D}; SchedXLN S; S.G = F.G; S.c = (int)blockIdx.x; S.A = MIXED; S.Bt = WOUT; S.K = D;
        EpiResidXLN<false> E{H, ws + WS_HLO, D, 0, (unsigned long long*)(ws + WS_XS1), F.ctl + CW_PAN1, F.ctl + CW_TMO2, F.lds + LDSCTL_OFF + 1024, nullptr, H1, ln1_g, ln1_b, ws + WS_H1Q};
        pg8::gemm_phase<EpiResidXLN<false>, SchedXLN, PG8_ALIGN, PG8_SP2>(F.lds + RING_OFF, g, S, E);
    }
    xcd_barrier(bar);

    {
        pg8::Gemm g{D / 2, D, D}; SchedFFN S; S.G = F.G; S.c = (int)blockIdx.x; S.AQ = (const char*)(ws + WS_H1Q); S.A = (const char*)H1; S.Bt = (const char*)WFFI;
        EpiSwiglu<true> E{ACT};
        pg8::gemm_phase<EpiSwiglu<true>, SchedFFN, PG8_ALIGN, false, true>(F.lds + RING_OFF, g, S, E);
        { QueueSrc Q{F.ctl + CW_Q2, w_ffn_down, WFFD, FF, D, 0, F.lane, 1 << 30}; run_pairs<QueueSrc, true>(Q, (LAS float*)(F.lds + RING_OFF + F.wave * 16384), F.lane); }
    }
    xcd_barrier(bar);

    {
        if (blockIdx.x == 0 && F.tid == 0 && xb_ld((unsigned*)(F.ctl + CW_BAR) + XB_TMO) != 0u) __hip_atomic_store(F.ctl + CW_TMO2, 1u, RLX_AGENT);
        pg8::Gemm g{FF, FF, FF}; SchedXLN S; S.G = F.G; S.c = (int)blockIdx.x; S.A = ACT; S.Bt = WFFD; S.K = FF;
        EpiResidXLN<true> E{H1, nullptr, 0, 0, (unsigned long long*)(ws + WS_XS2), F.ctl + CW_PAN2, F.ctl + CW_TMO2, F.lds + LDSCTL_OFF + 1024, out, nullptr, ln2_g, ln2_b, nullptr};
        pg8::gemm_phase<EpiResidXLN<true>, SchedXLN, PG8_ALIGN, PG8_SP2>(F.lds + RING_OFF, g, S, E);
    }
}

extern "C" void kernel_launch(void* const* d_in, const int* in_sizes, int n_in, void* d_out, int out_size, void* d_ws, size_t ws_size, hipStream_t stream) {
    static int grid = 0;
    if (grid == 0) {
        if (n_in != 18 || in_sizes[0] != M * D || out_size != M * D || ws_size < WS_END) { fprintf(stderr, "kernel_launch: unexpected shapes (n_in %d, in0 %d, out %d, ws %zu); nothing launched\n", n_in, n_in > 0 ? in_sizes[0] : -1, out_size, ws_size); grid = -1; return; }
        int dev = 0, cus = 0, per_cu = 0;
        if (hipGetDevice(&dev) != hipSuccess || hipDeviceGetAttribute(&cus, hipDeviceAttributeMultiprocessorCount, dev) != hipSuccess) { fprintf(stderr, "kernel_launch: device query failed\n"); grid = -1; return; }
        if (hipFuncSetAttribute((const void*)fwd_kernel, hipFuncAttributeMaxDynamicSharedMemorySize, LDS_BYTES) != hipSuccess) { fprintf(stderr, "kernel_launch: hipFuncSetAttribute failed\n"); grid = -1; return; }
        if (hipOccupancyMaxActiveBlocksPerMultiprocessor(&per_cu, (const void*)fwd_kernel, NWAVES * 64, LDS_BYTES) != hipSuccess || per_cu < 1)
            fprintf(stderr, "kernel_launch: note: occupancy query reports %d workgroups per CU\n", per_cu);
        (void)hipGetLastError();
        if (cus != 256) { fprintf(stderr, "kernel_launch: built for a 256-CU device (the in-phase LayerNorm needs one 256x256 tile per workgroup and round); found %d; nothing launched\n", cus); grid = -1; return; }
        grid = cus;
    }
    if (grid < 0) return;
    if (hipMemsetAsync((char*)d_ws + WS_CTL, 0, CTL_ZERO_BYTES, stream) != hipSuccess) { fprintf(stderr, "kernel_launch: memset failed\n"); return; }
    Args a{};
    for (int i = 0; i < 18; ++i) a.in[i] = (const float*)d_in[i];
    a.out = (float*)d_out; a.ws = (unsigned char*)d_ws;
    hipLaunchKernelGGL(fwd_kernel, dim3(grid), dim3(NWAVES * 64), LDS_BYTES, stream, a);
    const hipError_t le = hipPeekAtLastError();
    if (le != hipSuccess) fprintf(stderr, "kernel_launch: launch failed: %s\n", hipGetErrorName(le));
}
```

```cpp
#include <hip/hip_runtime.h>
#include <cstdio>
#include <cstdint>

namespace pg8 {
#define PG8_LAS __attribute__((address_space(3)))
typedef unsigned short bf16_t;
typedef short bf16x8 __attribute__((ext_vector_type(8)));
typedef float f32x4 __attribute__((ext_vector_type(4)));
typedef unsigned u32x4 __attribute__((ext_vector_type(4)));
typedef int i32x4 __attribute__((ext_vector_type(4)));
typedef int i32x8 __attribute__((ext_vector_type(8)));
constexpr int BM = 256, BK = 64, HALF = 128, HTB = HALF * BK * 2  , STAGE_BYTES = 8 * HTB, NXCD = 8, WGM = 8;

__host__ __device__ __forceinline__ int lds_byte(int r, int c) { const int st = (r >> 4) * 2 + (c >> 5), rr = r & 15, cc = c & 31, ob = rr * 64 + cc * 2; return st * 1024 + (ob ^ (((ob >> 9) & 1) << 5)); }
__host__ __device__ __forceinline__ void stage_rc(int b, int& R, int& C) { const int st = b / 1024, sb = b % 1024, swz = sb ^ (((sb >> 9) & 1) << 5); R = (st >> 1) * 16 + swz / 64; C = (st & 1) * 32 + (swz % 64) / 2; }
__host__ __device__ __forceinline__ int perm32(int rho) { const int n = rho >> 4, i = rho & 15; return 8 * (i >> 2) + 4 * n + (i & 3); }

struct Unit { int pm, pn, z; };
struct Gemm { int K, lda, ldb; };

__device__ __forceinline__ void tile_of(int L, int nM, int nN, int& pm, int& pn, int wgm = WGM) {
    const int nwg = nM * nN; int wgid = L;
    { const int q = nwg / NXCD, r = nwg % NXCD, xcd = wgid % NXCD, off = wgid / NXCD; wgid = (xcd < r ? xcd * (q + 1) : r * (q + 1) + (xcd - r) * q) + off; }
    const int nig = wgm * nN, gid = wgid / nig, fm = gid * wgm, gsz = (nM - fm) < wgm ? (nM - fm) : wgm;
    pm = fm + ((wgid % nig) % gsz); pn = (wgid % nig) / gsz;
}

__device__ __forceinline__ unsigned cvt_pk_bf16(float lo, float hi) { unsigned r; asm volatile("s_nop 0\n\tv_cvt_pk_bf16_f32 %0, %1, %2" : "=v"(r) : "v"(lo), "v"(hi)); return r; }
__device__ __forceinline__ float bf_lo(unsigned w) { return __uint_as_float(w << 16); }
__device__ __forceinline__ float bf_hi(unsigned w) { return __uint_as_float(w & 0xffff0000u); }
__device__ __forceinline__ float sigmoidf_fast(float x) { return __builtin_amdgcn_rcpf(1.0f + __builtin_amdgcn_exp2f(-1.44269504f * x)); }

template <class Epi, class Sched, bool ALIGN_EPI = false, bool SP2 = false, bool FP8 = false, int MIX = 0>
__device__ __forceinline__ void gemm_phase(PG8_LAS unsigned char* lds, const Gemm g, const Sched& S, const Epi& E) {
    int tid = threadIdx.x; asm volatile("" : "+v"(tid));
    const int wid = __builtin_amdgcn_readfirstlane(tid >> 6), lane = tid & 63, wr = wid >> 2, wc = wid & 3, fr = lane & 15, fq = lane >> 4;
    const int K = g.K, nt = K / BK;
    unsigned voffA[2], voffB[2];
#pragma unroll
    for (int i = 0; i < 2; ++i) { int R, C; stage_rc(tid * 16 + i * 8192, R, C); const int Rb = Epi::PERM ? ((R & ~31) + perm32(R & 31)) : R;
        voffA[i] = (unsigned)(R * g.lda + C) * 2u; voffB[i] = (unsigned)(Rb * g.ldb + C) * 2u; }
    const size_t kstep = (size_t)(BK * 2);
    const size_t hstepA = (size_t)HALF * g.lda * 2, hstepB = (size_t)HALF * g.ldb * 2;
    const unsigned ldsw = (unsigned)wid * 1024u;
    const int aoff = lds_byte(wr * 64 + fr, fq * 8), boff = lds_byte(wc * 32 + fr, fq * 8);
#define PG8_SA(b, h) (((b) * 2 + (h)) * HTB)
#define PG8_SB(b, h) ((4 + (b) * 2 + (h)) * HTB)
#define PG8_STAGE(bufoff, gbase, voff) do { _Pragma("unroll") for (int _i = 0; _i < 2; ++_i) \
        __builtin_amdgcn_global_load_lds((const unsigned*)((const char*)(gbase) + (voff)[_i]), (PG8_LAS unsigned*)(lds + (bufoff) + ldsw + _i * 8192), 16, 0, 0); } while (0)
#define PG8_LDA(dst, b, h) do { _Pragma("unroll") for (int m = 0; m < 4; ++m) _Pragma("unroll") for (int k = 0; k < 2; ++k) dst[m][k] = *(const PG8_LAS bf16x8*)(lds + PG8_SA(b, h) + aoff + m * 2048 + k * 1024); } while (0)
#define PG8_LDB(dst, b, h) do { _Pragma("unroll") for (int n = 0; n < 2; ++n) _Pragma("unroll") for (int k = 0; k < 2; ++k) dst[n][k] = *(const PG8_LAS bf16x8*)(lds + PG8_SB(b, h) + boff + n * 2048 + k * 1024); } while (0)
#define PG8_CAT8(x) __builtin_shufflevector(__builtin_bit_cast(i32x4, (x)[0]), __builtin_bit_cast(i32x4, (x)[1]), 0, 1, 2, 3, 4, 5, 6, 7)
#define PG8_MMA(ai, bj, At, Bt, F8) do { __builtin_amdgcn_s_setprio(1); _Pragma("unroll") for (int m = 0; m < 4; ++m) _Pragma("unroll") for (int n = 0; n < 2; ++n) { \
        if constexpr ((F8) == 1) { _Pragma("unroll") for (int k = 0; k < 2; ++k) \
            asm volatile("v_mfma_i32_16x16x64_i8 %0, %1, %2, %0" : "+v"(acc[ai][bj][m][n]) : "v"(Bt[n][k]), "v"(At[m][k]) : "memory"); }     \
        else { _Pragma("unroll") for (int k = 0; k < 2; ++k) acc[ai][bj][m][n] = __builtin_amdgcn_mfma_f32_16x16x32_bf16(Bt[n][k], At[m][k], acc[ai][bj][m][n], 0, 0, 0); } } \
        __builtin_amdgcn_s_setprio(0); } while (0)
#define PG8_SP2BODY(F8) do { \
            PG8_LDB(B0, 0, 0); PG8_LDB(B1, 0, 1); PG8_SCHED; PG8_LDA(At, 0, 0); PG8_STAGE(PG8_SA(1, 1), a1 + hstepA, voffA); \
            PG8_WAIT_V(8); PG8_WAIT_L(0); PG8_BAR; PG8_MMA(0, 0, At, B0, F8); PG8_MMA(0, 1, At, B1, F8); PG8_BAR; PG8_SCHED; \
            PG8_LDA(At, 0, 1); PG8_STAGE(PG8_SB(0, 0), b2, voffB); PG8_STAGE(PG8_SB(0, 1), b2 + hstepB, voffB); PG8_STAGE(PG8_SA(0, 0), a2, voffA); \
            PG8_WAIT_V(8); PG8_WAIT_L(0); PG8_BAR; PG8_MMA(1, 0, At, B0, F8); PG8_MMA(1, 1, At, B1, F8); PG8_BAR; PG8_SCHED; \
            PG8_LDB(B0, 1, 0); PG8_LDB(B1, 1, 1); PG8_SCHED; PG8_LDA(At, 1, 0); PG8_STAGE(PG8_SA(0, 1), a2 + hstepA, voffA); \
            PG8_WAIT_V(8); PG8_WAIT_L(0); PG8_BAR; PG8_MMA(0, 0, At, B0, F8); PG8_MMA(0, 1, At, B1, F8); PG8_BAR; PG8_SCHED; \
            PG8_LDA(At, 1, 1); PG8_STAGE(PG8_SB(1, 0), b3, voffB); PG8_STAGE(PG8_SB(1, 1), b3 + hstepB, voffB); PG8_STAGE(PG8_SA(1, 0), a3, voffA); \
            PG8_WAIT_V(8); PG8_WAIT_L(0); PG8_BAR; PG8_MMA(1, 0, At, B0, F8); PG8_MMA(1, 1, At, B1, F8); PG8_BAR; PG8_SCHED; } while (0)
#define PG8_WAIT_V(n) asm volatile("s_waitcnt vmcnt(" #n ")" ::: "memory")
#define PG8_WAIT_L(n) asm volatile("s_waitcnt lgkmcnt(" #n ")" ::: "memory")
#define PG8_BAR __builtin_amdgcn_s_barrier()
#define PG8_SCHED __builtin_amdgcn_sched_barrier(0)
    Unit cur, nxt; int ui = 0;
    if (!S.next(0, cur)) return;
    f32x4 acc[2][2][4][2];
#pragma unroll
    for (int a = 0; a < 2; ++a)
#pragma unroll
        for (int b = 0; b < 2; ++b)
#pragma unroll
            for (int m = 0; m < 4; ++m)
#pragma unroll
                for (int n = 0; n < 2; ++n) acc[a][b][m][n] = (f32x4){0.f, 0.f, 0.f, 0.f};
    int sc1_ = 0x7F7F7F7F; asm volatile("" : "+v"(sc1_));
    bf16x8 At[4][2], B0[2][2], B1[2][2];
    const char* cA; const char* cB; S.ptrs(cur, cA, cB);
    if constexpr (SP2) {
        PG8_STAGE(PG8_SB(0, 0), cB, voffB); PG8_STAGE(PG8_SB(0, 1), cB + hstepB, voffB); PG8_STAGE(PG8_SA(0, 0), cA, voffA); PG8_STAGE(PG8_SA(0, 1), cA + hstepA, voffA);
        if (wr == 1) PG8_BAR;
        PG8_WAIT_V(2); PG8_BAR;
        PG8_STAGE(PG8_SB(1, 0), cB + kstep, voffB); PG8_STAGE(PG8_SA(1, 0), cA + kstep, voffA); PG8_STAGE(PG8_SB(1, 1), cB + hstepB + kstep, voffB);
        PG8_WAIT_V(6); PG8_BAR;
    } else {
        PG8_STAGE(PG8_SB(0, 0), cB, voffB); PG8_STAGE(PG8_SA(0, 0), cA, voffA); PG8_STAGE(PG8_SB(0, 1), cB + hstepB, voffB); PG8_STAGE(PG8_SA(0, 1), cA + hstepA, voffA);
        if (wr == 1) PG8_BAR;
        PG8_WAIT_V(4); PG8_BAR;
        PG8_STAGE(PG8_SB(1, 0), cB + kstep, voffB); PG8_STAGE(PG8_SA(1, 0), cA + kstep, voffA); PG8_STAGE(PG8_SB(1, 1), cB + hstepB + kstep, voffB);
        PG8_WAIT_V(6); PG8_BAR;
    }
    for (;;) {
        const bool has_next = S.next(ui + 1, nxt);
        const char* nA = cA; const char* nB = cB; if (has_next) S.ptrs(nxt, nA, nB);
#define PG8_TLOOP_HEAD(CA, CB, NA, NB, NTC) for (int t = 0; t < (NTC); t += 2) { \
            const bool last = (t == (NTC) - 2); \
            const char* a1 = (CA) + (size_t)(t + 1) * kstep; \
            const char* a2 = last ? (NA) : (CA) + (size_t)(t + 2) * kstep; const char* b2 = last ? (NB) : (CB) + (size_t)(t + 2) * kstep; \
            const char* a3 = a2 + kstep; const char* b3 = b2 + kstep;
#define PG8_EPI_CALL(call) do { asm volatile("s_nop 15\n\ts_nop 15" ::: "memory"); if constexpr (ALIGN_EPI) { if (wr == 0) PG8_BAR; } call; if constexpr (ALIGN_EPI) { if (wr == 1) PG8_BAR; } } while (0)
#define PG8_ZERO_ACC do { _Pragma("unroll") for (int a = 0; a < 2; ++a) _Pragma("unroll") for (int b = 0; b < 2; ++b) _Pragma("unroll") for (int m = 0; m < 4; ++m) _Pragma("unroll") for (int n = 0; n < 2; ++n) acc[a][b][m][n] = (f32x4){0.f, 0.f, 0.f, 0.f}; } while (0)
        if constexpr (MIX == 2) {
            const char* mA; const char* mB; S.ptrs2(cur, mA, mB);
            PG8_TLOOP_HEAD(cA, cB, mA, mB, Sched::NT0) PG8_SP2BODY(1); }
            PG8_EPI_CALL(E.mid(acc, cur, wr, wc, fr, fq));
            PG8_TLOOP_HEAD(mA, mB, nA, nB, nt) PG8_SP2BODY(0); }
        } else if constexpr (MIX == 1) {
            const char *g2B, *fA, *fB, *mA, *mB; S.ptrs_all(cur, g2B, fA, fB, mA, mB);
            PG8_TLOOP_HEAD(cA, cB, cA, g2B, nt) PG8_SP2BODY(1); }
            PG8_EPI_CALL(E.gate(acc, cur, 0, wr, wc, fr, fq)); PG8_ZERO_ACC;
            PG8_TLOOP_HEAD(cA, g2B, fA, fB, nt) PG8_SP2BODY(1); }
            PG8_EPI_CALL(E.gate(acc, cur, 1, wr, wc, fr, fq)); PG8_ZERO_ACC;
            PG8_TLOOP_HEAD(fA, fB, mA, mB, nt >> 1) PG8_SP2BODY(1); }
            PG8_EPI_CALL(E.mid(acc, cur, wr, wc, fr, fq));
            PG8_TLOOP_HEAD(mA, mB, nA, nB, nt) PG8_SP2BODY(0); }
        } else {
        PG8_TLOOP_HEAD(cA, cB, nA, nB, nt)
            if constexpr (SP2) {
            PG8_SP2BODY(FP8 ? 1 : 0);
            } else {
            PG8_LDB(B0, 0, 0); PG8_SCHED; PG8_LDA(At, 0, 0); PG8_STAGE(PG8_SA(1, 1), a1 + hstepA, voffA);
            PG8_WAIT_L(8); PG8_BAR; PG8_WAIT_L(0); PG8_MMA(0, 0, At, B0, FP8); PG8_BAR; PG8_SCHED;
            PG8_LDB(B1, 0, 1); PG8_STAGE(PG8_SB(0, 0), b2, voffB);
            PG8_BAR; PG8_WAIT_L(0); PG8_MMA(0, 1, At, B1, FP8); PG8_BAR;
            PG8_LDA(At, 0, 1); PG8_STAGE(PG8_SA(0, 0), a2, voffA);
            PG8_BAR; PG8_WAIT_L(0); PG8_MMA(1, 0, At, B0, FP8); PG8_BAR; PG8_SCHED;
            PG8_STAGE(PG8_SB(0, 1), b2 + hstepB, voffB);
            PG8_WAIT_V(6); PG8_BAR; PG8_MMA(1, 1, At, B1, FP8); PG8_BAR;
            PG8_LDB(B0, 1, 0); PG8_SCHED; PG8_LDA(At, 1, 0); PG8_STAGE(PG8_SA(0, 1), a2 + hstepA, voffA);
            PG8_WAIT_L(8); PG8_BAR; PG8_WAIT_L(0); PG8_MMA(0, 0, At, B0, FP8); PG8_BAR; PG8_SCHED;
            PG8_LDB(B1, 1, 1); PG8_STAGE(PG8_SB(1, 0), b3, voffB);
            PG8_BAR; PG8_WAIT_L(0); PG8_MMA(0, 1, At, B1, FP8); PG8_BAR;
            PG8_LDA(At, 1, 1); PG8_STAGE(PG8_SA(1, 0), a3, voffA);
            PG8_BAR; PG8_WAIT_L(0); PG8_MMA(1, 0, At, B0, FP8); PG8_BAR; PG8_SCHED;
            PG8_STAGE(PG8_SB(1, 1), b3 + hstepB, voffB);
            PG8_WAIT_V(6); PG8_BAR; PG8_MMA(1, 1, At, B1, FP8); PG8_BAR;
            }
        }
        }
#undef PG8_TLOOP_HEAD
#undef PG8_EPI_CALL
#undef PG8_ZERO_ACC
        if constexpr (FP8) asm volatile("s_nop 15\n\ts_nop 15" ::: "memory");
        if constexpr (ALIGN_EPI) { if (wr == 0) PG8_BAR; }
        E(acc, cur, wr, wc, fr, fq);
        if (!has_next) break;
        {
#pragma unroll
        for (int a = 0; a < 2; ++a)
#pragma unroll
            for (int b = 0; b < 2; ++b)
#pragma unroll
                for (int m = 0; m < 4; ++m)
#pragma unroll
                    for (int n = 0; n < 2; ++n) acc[a][b][m][n] = (f32x4){0.f, 0.f, 0.f, 0.f};
        }
        cur = nxt; cA = nA; cB = nB; ++ui;
        if constexpr (ALIGN_EPI) { if (wr == 1) PG8_BAR; }
    }
    PG8_WAIT_V(0);
    if constexpr (!ALIGN_EPI) { if (wr == 0) PG8_BAR; }
    PG8_BAR;
#undef PG8_SA
#undef PG8_SB
#undef PG8_STAGE
#undef PG8_LDA
#undef PG8_LDB
#undef PG8_MMA
#undef PG8_SP2BODY
#undef PG8_CAT8
#undef PG8_WAIT_V
#undef PG8_WAIT_L
#undef PG8_BAR
#undef PG8_SCHED
}
}

#ifndef PG8_SP2
#define PG8_SP2 true
#endif
#ifndef PG8_ALIGN
#define PG8_ALIGN true
#endif

constexpr int NWAVES = 8;
constexpr int BATCH = 4, SEQ = 4096, D = 4096, NMETA = 16;
constexpr int M = BATCH * SEQ;
constexpr int MX = M + 256;
constexpr int AW = 2048, KVW = 256, PW = 2048, INW = 12800;
constexpr int FF = 11008;
constexpr float LN_EPS = 1e-5f;
constexpr float DN_ALPHA = 1.189207115002721f;
constexpr int NPOS = SEQ + NMETA;

constexpr size_t MiB = 1u << 20;
constexpr size_t WS_CTL = 0, CTL_ZERO_BYTES = 1 * MiB;
constexpr size_t WS_ROPE = 1 * MiB;
constexpr size_t WS_WIN = 2 * MiB;
constexpr size_t WS_WAU = 102 * MiB;
constexpr size_t WS_WPG = 134 * MiB;
constexpr size_t WS_WOUT = 136 * MiB;
constexpr size_t WS_WFFI = 168 * MiB;
constexpr size_t WS_WFFD = 340 * MiB;
constexpr size_t WS_H = 426 * MiB;
constexpr size_t WS_Q = 556 * MiB;
constexpr size_t WS_K = 620 * MiB;
constexpr size_t WS_V = 629 * MiB;
constexpr size_t WS_U = 638 * MiB;
constexpr size_t WS_GA = 703 * MiB;
constexpr size_t WS_GSLAB = 703 * MiB;
constexpr size_t WS_WPT = 959 * MiB;
constexpr size_t WS_HLO = 768 * MiB;
constexpr size_t WS_H1Q = 2 * MiB;
constexpr size_t WS_POOLED = WS_WIN;
constexpr size_t WS_MIXED = WS_Q;
constexpr size_t WS_H1 = WS_H;
constexpr size_t WS_ACT = WS_GA;
constexpr size_t WS_XS1 = 1087 * MiB, WS_XS2 = 1089 * MiB;
constexpr size_t WS_H8 = 1092 * MiB;
constexpr size_t WS_WG8 = 1158 * MiB;
constexpr size_t WS_W8P = 1190 * MiB;
constexpr size_t WS_ATT8 = 976 * MiB;
constexpr size_t WS_W8AU = 1040 * MiB;
constexpr size_t WS_END = 1208 * MiB;
static_assert(WS_WPT + (size_t)D * PW * 2 <= WS_ATT8 && WS_ATT8 + (size_t)M * 4096 <= WS_W8AU && WS_W8AU + (size_t)D * 4096 <= WS_XS1, "P3 operand map");
static_assert(WS_WIN + (size_t)INW * D * 2 <= WS_WAU && WS_WFFI + (size_t)2 * FF * D * 2 <= WS_WFFD && WS_WFFD + (size_t)D * FF * 2 <= WS_H, "weights map");
static_assert(WS_H + (size_t)MX * D * 2 <= WS_Q && WS_K + (size_t)MX * KVW * 2 <= WS_V && WS_V + (size_t)MX * KVW * 2 <= WS_U && WS_U + (size_t)MX * PW * 2 <= WS_GA, "act map");
static_assert(WS_MIXED + (size_t)M * D * 2 <= WS_GA && WS_ACT + (size_t)M * FF * 2 <= WS_XS1 && WS_WPT + (size_t)D * PW * 2 <= WS_XS1, "overlay map");
constexpr int CW_BAR = 4096;
constexpr int CW_Q2 = 128, CW_TMO2 = 192;
constexpr int CW_PAN1 = 16384, CW_PAN2 = 16384 + 64 * 64;
constexpr size_t WS_ST0 = 1 * MiB + 512 * 1024;

constexpr int RING_OFF = 0, RING_BYTES = 131072;
constexpr int LDSCTL_OFF = RING_BYTES, MISC_OFF = LDSCTL_OFF + 320;
constexpr int LDS_BYTES = 147456;

#define GAS __attribute__((address_space(1)))
#define LAS __attribute__((address_space(3)))
typedef unsigned short bf16;
typedef unsigned v4u __attribute__((ext_vector_type(4)));
typedef unsigned v2u __attribute__((ext_vector_type(2)));
typedef float f32x4 __attribute__((ext_vector_type(4)));
typedef GAS unsigned gu32;
#define RLX_AGENT __ATOMIC_RELAXED, __HIP_MEMORY_SCOPE_AGENT
#define LDS_WAIT() asm volatile("s_waitcnt lgkmcnt(0)" ::: "memory")
#define VM_WAIT() asm volatile("s_waitcnt vmcnt(0)" ::: "memory")
__device__ __forceinline__ unsigned f2bf(float f) { unsigned u = __builtin_bit_cast(unsigned, f); return (u + 0x7fffu + ((u >> 16) & 1u)) >> 16; }
__device__ __forceinline__ unsigned pk2(float lo, float hi) { return pg8::cvt_pk_bf16(lo, hi); }

#define XB_TMO      128
#define XB_XCNT(j)  (256  + 64 * (j))
#define XB_XSUB(j)  (1280 + 64 * (j))
#define XB_XGEN(j)  (2304 + 64 * (j))
#define XB_TOP      3328
#define XB_TOPGEN   3392
#define XCD_BAR_WORDS 3456
#define XB_SPIN_CAP (1u << 18)

__device__ __forceinline__ unsigned xb_ld(unsigned* p)              { return __hip_atomic_load(p, __ATOMIC_RELAXED, __HIP_MEMORY_SCOPE_AGENT); }
__device__ __forceinline__ unsigned xb_add(unsigned* p, unsigned v) { return __hip_atomic_fetch_add(p, v, __ATOMIC_RELAXED, __HIP_MEMORY_SCOPE_AGENT); }
__device__ __forceinline__ unsigned xb_xcc_id() { return (unsigned)__builtin_amdgcn_s_getreg((3 << 11) | 20) & 0xFu; }
#define XB_SPIN(cond, bar) do { unsigned _sp = 0; while (cond) { __builtin_amdgcn_s_sleep(1); \
    if ((++_sp & 255u) == 0u) { if (xb_ld(&(bar)[XB_TMO])) break; if (_sp > XB_SPIN_CAP) { atomicAdd(&(bar)[XB_TMO], 1u); break; } } } } while (0)

struct XcdBarrier { unsigned* bar; unsigned x; volatile LAS unsigned* st; };

__device__ __forceinline__ XcdBarrier xcd_barrier_post(unsigned* bar, volatile LAS unsigned* st) {
    XcdBarrier b; b.bar = bar; b.x = xb_xcc_id(); b.st = st;
    if (threadIdx.x == 0) (void)xb_add(&bar[XB_XCNT(b.x)], 1u);
    return b;
}
__device__ __forceinline__ void xcd_barrier_complete(unsigned* bar, unsigned x, unsigned& nloc, unsigned& nx) {
    const unsigned G = gridDim.x * gridDim.y * gridDim.z;
    unsigned sum, cnt, mine, sp = 0u;
    for (;;) {
        sum = 0u; cnt = 0u; mine = 0u;
#pragma unroll
        for (unsigned j = 0; j < 16; ++j) { const unsigned c = xb_ld(&bar[XB_XCNT(j)]); sum += c; cnt += (c > 0u) ? 1u : 0u; mine = (j == x) ? c : mine; }
        if (sum == G) break;
        __builtin_amdgcn_s_sleep(1);
        if ((++sp & 255u) == 0u) { if (xb_ld(&bar[XB_TMO])) break; if (sp > XB_SPIN_CAP) { atomicAdd(&bar[XB_TMO], 1u); break; } }
    }
    nloc = mine > 0u ? mine : 1u; nx = cnt > 0u ? cnt : 1u;
}
__device__ __forceinline__ void xcd_barrier(const XcdBarrier& b) {
    asm volatile("s_waitcnt vmcnt(0)" ::: "memory");
    __syncthreads();
    if (threadIdx.x == 0) {
        unsigned* bar = b.bar;
        __builtin_amdgcn_s_waitcnt(0);
        unsigned nloc = b.st[0], nx = b.st[1];
        if (nloc == 0u) { xcd_barrier_complete(bar, b.x, nloc, nx); b.st[0] = nloc; b.st[1] = nx; }
        const unsigned old = xb_add(&bar[XB_XSUB(b.x)], 1u);
        const unsigned gen = old / nloc;
        if (old + 1u == (gen + 1u) * nloc) {
            __builtin_amdgcn_fence(__ATOMIC_RELEASE, "agent");
            asm volatile("s_waitcnt vmcnt(0)" ::: "memory");
            const unsigned og = xb_add(&bar[XB_TOP], 1u);
            const unsigned tg = og / nx;
            if (og + 1u == (tg + 1u) * nx) xb_add(&bar[XB_TOPGEN], 1u);
            else XB_SPIN(xb_ld(&bar[XB_TOPGEN]) == tg, bar);
            __builtin_amdgcn_fence(__ATOMIC_ACQUIRE, "agent");
            xb_add(&bar[XB_XGEN(b.x)], 1u);
            asm volatile("s_waitcnt vmcnt(0)" ::: "memory");
        } else {
            XB_SPIN(xb_ld(&bar[XB_XGEN(b.x)]) == gen, bar);
            __builtin_amdgcn_fence(__ATOMIC_ACQUIRE, "agent");
            asm volatile("s_waitcnt vmcnt(0)" ::: "memory");
        }
    }
    __syncthreads();
}

struct Args { const float* in[18]; float* out; unsigned char* ws; };

struct Frame {
    LAS unsigned char* lds;
    volatile LAS unsigned* MISC;
    gu32* ctl;
    int tid, lane, wave, G;
};

__device__ __forceinline__ float wave_sum(float v) {
#pragma unroll
    for (int o = 1; o < 64; o <<= 1) v += __shfl_xor(v, o);
    return v;
}

__device__ __forceinline__ int drow_of(int n0, int mode) {
    int drow = n0;
    if (mode == 3) { const int gcol = n0 - 4608, br = gcol >> 12, ch = gcol & 4095; drow = 256 * (ch >> 7) + 128 * br + (ch & 127); }
    else if (mode == 2) { if (n0 < FF) drow = 256 * (n0 >> 7) + (n0 & 127); else { const int ch = n0 - FF; drow = 256 * (ch >> 7) + 128 + (ch & 127); } }
    return drow;
}
constexpr int KQ = 4096;
constexpr float H8_SCALE = 31.75f, W8_SCALE = 2032.0f, WAU8_SCALE = 1437.0f, G8_UNSCALE = 1.0f / (31.75f * 2032.0f), ATT8_SCALE = 100.0f, AU8_UNSCALE = 1.0f / (100.0f * 1437.0f);
__device__ __forceinline__ unsigned pk4_fp8(float a, float b, float c, float d) {
    const int ia = (int)__builtin_rintf(__builtin_amdgcn_fmed3f(a, -127.f, 127.f)), ib = (int)__builtin_rintf(__builtin_amdgcn_fmed3f(b, -127.f, 127.f));
    const int ic = (int)__builtin_rintf(__builtin_amdgcn_fmed3f(c, -127.f, 127.f)), id = (int)__builtin_rintf(__builtin_amdgcn_fmed3f(d, -127.f, 127.f));
    return (unsigned)(ia & 255) | ((unsigned)(ib & 255) << 8) | ((unsigned)(ic & 255) << 16) | ((unsigned)id << 24); }
__device__ __forceinline__ float lo_of(float x, float b) { const unsigned E = (__float_as_uint(b) >> 23) & 255u; const float sc = __uint_as_float((261u - E) << 23);
    return (E >= 16u && E <= 250u) ? (x - b) * sc * 254.0f : 0.0f; }
__device__ __forceinline__ float ulp254(float b) { const unsigned E = (__float_as_uint(b) >> 23) & 255u; return E >= 16u ? __uint_as_float((E - 7u) << 23) * (1.0f / 254.0f) : 0.0f; }
__device__ __forceinline__ unsigned pk2_q12(float a, float b) {
    const int ia = (int)__builtin_rintf(__builtin_amdgcn_fmed3f(a * 4096.0f, -32767.f, 32767.f)), ib = (int)__builtin_rintf(__builtin_amdgcn_fmed3f(b * 4096.0f, -32767.f, 32767.f));
    return (unsigned)(ia & 0xFFFF) | ((unsigned)ib << 16); }
__device__ __forceinline__ float q12_lo(unsigned w) { return (float)((int)(w << 16) >> 16) * (1.0f / 4096.0f); }
__device__ __forceinline__ float q12_hi(unsigned w) { return (float)((int)w >> 16) * (1.0f / 4096.0f); }
__device__ __forceinline__ float sb(unsigned w, int i) { return (float)((int)(w << (24 - 8 * i)) >> 24); }
struct PairDesc { const float* W; bf16* WT; int K, N, k0, n0, mode; };
template <bool NT>
__device__ __forceinline__ void pair_load(const PairDesc& p, f32x4 (&v)[16], int lane) {
    const float* src = p.W + (size_t)(p.k0 + (lane >> 3)) * p.N + p.n0 + (lane & 7) * 4;
#pragma unroll
    for (int i = 0; i < 16; ++i) { const f32x4* q = (const f32x4*)(src + (size_t)(8 * (i & 7)) * p.N + 32 * (i >> 3)); v[i] = NT ? __builtin_nontemporal_load(q) : *q; }
}
__device__ __forceinline__ void pair_store(const PairDesc& p, const f32x4 (&v)[16], LAS float* scr, int lane) {
#pragma unroll
    for (int hh = 0; hh < 2; ++hh) {
        const int drow0 = drow_of(p.n0 + 32 * hh, p.mode);
#pragma unroll
        for (int i = 0; i < 8; ++i) { LAS float* d = scr + (8 * i + (lane >> 3)) * 33 + (lane & 7) * 4; const f32x4 x = v[8 * hh + i]; d[0] = x.x; d[1] = x.y; d[2] = x.z; d[3] = x.w; }
        LDS_WAIT(); asm volatile("" ::: "memory");
        const int c = lane & 7;
#pragma unroll
        for (int j = 0; j < 4; ++j) { const int n = (lane >> 3) + 8 * j; const LAS float* s = scr + (8 * c) * 33 + n;
            if (p.mode >= 3 || (p.mode == 2 && p.k0 < KQ)) { const float q8 = p.mode == 5 ? WAU8_SCALE : W8_SCALE; const size_t pitchb = p.mode == 2 ? (size_t)p.K * 2 : (size_t)p.K; v2u o; o.x = pk4_fp8(s[0 * 33] * q8, s[1 * 33] * q8, s[2 * 33] * q8, s[3 * 33] * q8); o.y = pk4_fp8(s[4 * 33] * q8, s[5 * 33] * q8, s[6 * 33] * q8, s[7 * 33] * q8);
                *(v2u*)((unsigned char*)p.WT + (size_t)(drow0 + n) * pitchb + p.k0 + 8 * c) = o; }
            else { v4u o; o.x = pk2(s[0 * 33], s[1 * 33]); o.y = pk2(s[2 * 33], s[3 * 33]); o.z = pk2(s[4 * 33], s[5 * 33]); o.w = pk2(s[6 * 33], s[7 * 33]);
                *(v4u*)(p.WT + (size_t)(drow0 + n) * p.K + p.k0 + 8 * c) = o; } }
        LDS_WAIT(); asm volatile("" ::: "memory");
    }
}
template <class Src, bool NT>
__device__ __forceinline__ void run_pairs(Src& S, LAS float* scr, int lane) {
    PairDesc a, b; f32x4 va[16], vb[16];
    if (!S.next(a)) return;
    pair_load<NT>(a, va, lane);
    for (;;) {
        const bool hb = S.next(b); if (hb) pair_load<NT>(b, vb, lane);
        pair_store(a, va, scr, lane);
        if (!hb) break;
        const bool ha = S.next(a); if (ha) pair_load<NT>(a, va, lane);
        pair_store(b, vb, scr, lane);
        if (!ha) break;
    }
}
struct QueueSrc {
    gu32* head; const float* W; bf16* WT; int K, N, mode, lane, left;
    __device__ __forceinline__ bool next(PairDesc& p) {
        if (left-- <= 0) return false;
        unsigned it = 0; if (lane == 0) it = __hip_atomic_fetch_add(head, 1u, __ATOMIC_RELAXED, __HIP_MEMORY_SCOPE_AGENT);
        it = (unsigned)__builtin_amdgcn_readfirstlane((int)it);
        const int npb = N / 64; if (it >= (unsigned)((K / 64) * npb)) return false;
        p.W = W; p.WT = WT; p.K = K; p.N = N; p.mode = mode; p.k0 = 64 * ((int)it / npb); p.n0 = 64 * ((int)it % npb); return true; }
};
struct P0Src {
    int it, stride; const float *w_in, *w_au, *w_pu, *w_pg, *w_out, *w_ffi; bf16 *WIN, *WAU, *WPG, *WOUT, *WFFI; unsigned char *WG8, *W8P, *W8AU; int pend_k0, pend_n0;
    __device__ __forceinline__ bool next(PairDesc& p) {
        if (pend_k0 >= 0) { p.W = w_in; p.WT = (bf16*)WG8; p.K = D; p.N = INW; p.mode = 3; p.k0 = pend_k0; p.n0 = pend_n0; pend_k0 = -1; return true; }
        constexpr int P_IN = (D / 64) * (2048 / 64), P_P8 = (D / 64) * (4608 / 64), P_G8 = (D / 128) * (8192 / 64), P_AU = (AW / 64) * (D / 64), P_PU = P_AU, P_OUT = (D / 64) * (D / 64);
        constexpr int P_FFI = (D / 64) * (2 * FF / 64);
        constexpr int NPAIRS = P_IN + P_P8 + P_G8 + P_AU + P_PU + P_OUT + P_FFI;
        if (it >= NPAIRS) return false;
        int r = it; it += stride; int pair; int npb = 0, nbase = 0;
        if (r < P_IN) { p.W = w_in; p.WT = WIN; p.K = D; p.N = INW; p.mode = 0; pair = r; npb = 2048 / 64; nbase = 2560; }
        else if ((r -= P_IN) < P_P8) { p.W = w_in; p.WT = (bf16*)W8P; p.K = D; p.N = INW; p.mode = 4; pair = r; npb = 4608 / 64; }
        else if ((r -= P_P8) < P_G8) {
            p.W = w_in; p.WT = (bf16*)WG8; p.K = D; p.N = INW; p.mode = 3; p.k0 = 128 * (r / 128); p.n0 = 4608 + 64 * (r % 128); pend_k0 = p.k0 + 64; pend_n0 = p.n0; return true; }
        else if ((r -= P_G8) < P_AU) { p.W = w_au; p.WT = (bf16*)W8AU; p.K = 2 * AW; p.N = D; p.mode = 5; pair = r; }
        else if ((r -= P_AU) < P_PU) { p.W = w_pu; p.WT = WAU + AW; p.K = D; p.N = D; p.mode = 0; pair = r; }
        else if ((r -= P_PU) < P_OUT) { p.W = w_out; p.WT = WOUT; p.K = D; p.N = D; p.mode = 0; pair = r; }
        else { r -= P_OUT; p.W = w_ffi; p.WT = WFFI; p.K = D; p.N = 2 * FF; p.mode = 2; pair = r; }
        if (npb == 0) npb = p.N / 64; p.k0 = 64 * (pair / npb); p.n0 = nbase + 64 * (pair % npb); return true; }
};

__device__ __forceinline__ void ln_row(const float* src, bf16* dstb, unsigned char* dst8, unsigned char* dstlo, const float* g, const float* bt, int lane) {
    f32x4 v[16]; float s = 0.f;
#pragma unroll
    for (int j = 0; j < 16; ++j) v[j] = ((const f32x4*)src)[lane + 64 * j];
    f32x4 ga[4], ba[4];
#pragma unroll
    for (int jj = 0; jj < 4; ++jj) { ga[jj] = ((const f32x4*)g)[lane + 64 * jj]; ba[jj] = ((const f32x4*)bt)[lane + 64 * jj]; }
#pragma unroll
    for (int j = 0; j < 16; ++j) s += (v[j].x + v[j].y) + (v[j].z + v[j].w);
    const float mean = wave_sum(s) * (1.f / D); float s2 = 0.f;
#pragma unroll
    for (int j = 0; j < 16; ++j) { v[j] = v[j] - mean; s2 += (v[j].x * v[j].x + v[j].y * v[j].y) + (v[j].z * v[j].z + v[j].w * v[j].w); }
    const float rstd = 1.f / sqrtf(wave_sum(s2) * (1.f / D) + LN_EPS);
#pragma unroll
    for (int k = 0; k < 4; ++k) {
        f32x4 gn[4], bn[4];
        if (k < 3) {
#pragma unroll
            for (int jj = 0; jj < 4; ++jj) { gn[jj] = ((const f32x4*)g)[lane + 64 * (4 * k + 4 + jj)]; bn[jj] = ((const f32x4*)bt)[lane + 64 * (4 * k + 4 + jj)]; } }
#pragma unroll
        for (int jj = 0; jj < 4; ++jj) { const int j = 4 * k + jj;
            const f32x4 y = v[j] * rstd * ga[jj] + ba[jj];
            v2u w; w.x = pk2(y.x, y.y); w.y = pk2(y.z, y.w); ((v2u*)dstb)[lane + 64 * j] = w;
            ((unsigned*)dst8)[lane + 64 * j] = pk4_fp8(y.x * H8_SCALE, y.y * H8_SCALE, y.z * H8_SCALE, y.w * H8_SCALE);
            ((unsigned*)dstlo)[lane + 64 * j] = pk4_fp8(lo_of(y.x, pg8::bf_lo(w.x)), lo_of(y.y, pg8::bf_hi(w.x)), lo_of(y.z, pg8::bf_lo(w.y)), lo_of(y.w, pg8::bf_hi(w.y))); }
        if (k < 3) {
#pragma unroll
            for (int jj = 0; jj < 4; ++jj) { ga[jj] = gn[jj]; ba[jj] = bn[jj]; } }
    }
}

__device__ __forceinline__ void sincos_d(float af, float& sn, float& cs) {
    const double a = (double)af;
    const double q = __builtin_rint(a * 0.63661977236758134308);
    const double r = (a - q * 1.57079632679489655800) - q * 6.12323399573676603587e-17;
    const double r2 = r * r;
    double sp = r * (1.0 + r2 * (-1.66666666666666657415e-01 + r2 * (8.33333333333309497557e-03 + r2 * (-1.98412698412589187999e-04 + r2 * (2.75573192104428224777e-06 + r2 * (-2.50519113340291937613e-08 + r2 * 1.58969099521155010221e-10))))));
    double cp = 1.0 + r2 * (-0.5 + r2 * (4.16666666666666019037e-02 + r2 * (-1.38888888888741095749e-03 + r2 * (2.48015872894767294178e-05 + r2 * (-2.75573143513906633035e-07 + r2 * (2.08757232129817482790e-09 + r2 * -1.13596475577881948265e-11))))));
    const int qi = (int)q & 3;
    const double s_ = (qi & 1) ? cp : sp, c_ = (qi & 1) ? sp : cp;
    sn = (float)((qi & 2) ? -s_ : s_);
    cs = (float)(((qi + 1) & 2) ? -c_ : c_);
}

typedef float f32x16 __attribute__((ext_vector_type(16)));
typedef short s16x4 __attribute__((ext_vector_type(4)));
__device__ __forceinline__ s16x4 vtr(const LAS unsigned char* p) { return __builtin_bit_cast(s16x4, __builtin_amdgcn_ds_read_tr16_b64_v4i16((LAS s16x4*)p)); }

__device__ __forceinline__ void acc8(float (&a)[8], const v4u& w) {
    a[0] += pg8::bf_lo(w.x); a[1] += pg8::bf_hi(w.x); a[2] += pg8::bf_lo(w.y); a[3] += pg8::bf_hi(w.y); a[4] += pg8::bf_lo(w.z); a[5] += pg8::bf_hi(w.z); a[6] += pg8::bf_lo(w.w); a[7] += pg8::bf_hi(w.w); }
template <int W>
__device__ __forceinline__ void pool_task(const bf16* UB, bf16* POOLED, int b, int run, int g, int lane) {
    const int t0 = run * 32; const size_t coff = (size_t)g * 512 + 8 * lane;
    v4u win[W - 1 + 8];
#pragma unroll
    for (int j = 0; j < W - 1; ++j) { const int tt = t0 - (W - 1) + j; const int srow = tt >= 0 ? b * SEQ + tt : M + NMETA + tt; win[j] = *(const v4u*)(UB + (size_t)srow * PW + coff); }
#pragma unroll 1
    for (int blk = 0; blk < 4; ++blk) {
        const int tb = t0 + 8 * blk;
#pragma unroll
        for (int o = 0; o < 8; ++o) win[W - 1 + o] = *(const v4u*)(UB + (size_t)(b * SEQ + tb + o) * PW + coff);
#pragma unroll
        for (int o = 0; o < 8; ++o) {
            float a[8];
#pragma unroll
            for (int e = 0; e < 8; ++e) a[e] = 0.f;
#pragma unroll
            for (int i = 0; i < W; ++i) acc8(a, win[W - 1 + o - i]);
            float s[8];
#pragma unroll
            for (int e = 0; e < 8; ++e) s[e] = 0.f;
            acc8(s, win[W - 1 + o]);
            const float rw = 1.0f / (float)W; v4u ow;
            ow.x = pk2(a[0] * rw - s[0], a[1] * rw - s[1]); ow.y = pk2(a[2] * rw - s[2], a[3] * rw - s[3]);
            ow.z = pk2(a[4] * rw - s[4], a[5] * rw - s[5]); ow.w = pk2(a[6] * rw - s[6], a[7] * rw - s[7]);
            *(v4u*)(POOLED + (size_t)(b * SEQ + tb + o) * PW + coff) = ow;
        }
#pragma unroll
        for (int j = 0; j < W - 1; ++j) win[j] = win[j + 8];
    }
}

struct SchedBase { int G, c; };
struct SchedF8 : SchedBase {
    const unsigned char *A, *BP;
    __device__ __forceinline__ bool next(int i, pg8::Unit& u) const {
        const int L = i * G + c; if (L >= 650) return false;
        if (L < 640) pg8::tile_of(L, 64, 10, u.pm, u.pn); else { u.pm = 64; u.pn = 8 + (L - 640); }
        u.z = 1; return true; }
    __device__ __forceinline__ void ptrs(const pg8::Unit& u, const char*& a, const char*& b) const { a = (const char*)A + (size_t)u.pm * 256 * D; b = (const char*)BP + (size_t)u.pn * 256 * D; }
};
struct SchedProj : SchedBase {
    const bf16* A; const bf16* Bt;
    __device__ __forceinline__ bool next(int i, pg8::Unit& u) const {
        const int L = i * G + c; if (L >= 512) return false;
        pg8::tile_of(L, 64, 8, u.pm, u.pn); u.pn += 10; u.z = 0; return true; }
    __device__ __forceinline__ void ptrs(const pg8::Unit& u, const char*& a, const char*& b) const { a = (const char*)A + (size_t)u.pm * 256 * D * 2; b = (const char*)Bt + (size_t)u.pn * 256 * D * 2; }
};
struct SchedPlain : SchedBase {
    const bf16* A; const bf16* Bt; int nM, nN, K, wgm;
    __device__ __forceinline__ bool next(int i, pg8::Unit& u) const { const int L = i * G + c; if (L >= nM * nN) return false; pg8::tile_of(L, nM, nN, u.pm, u.pn, wgm); u.z = 0; return true; }
    __device__ __forceinline__ void ptrs(const pg8::Unit& u, const char*& a, const char*& b) const { a = (const char*)A + (size_t)u.pm * 256 * K * 2; b = (const char*)Bt + (size_t)u.pn * 256 * K * 2; }
};
struct SchedXLN : SchedBase {
    const bf16* A; const bf16* Bt; int K;
    __device__ __forceinline__ bool next(int i, pg8::Unit& u) const { if (i >= 4) return false; const int x = c & 7, sl = c >> 3; u.pm = 4 * (4 * i + (x >> 1)) + (sl & 3); u.pn = 8 * (x & 1) + (sl >> 2); u.z = 0; return true; }
    __device__ __forceinline__ void ptrs(const pg8::Unit& u, const char*& a, const char*& b) const { a = (const char*)A + (size_t)u.pm * 256 * K * 2; b = (const char*)Bt + (size_t)u.pn * 256 * K * 2; }
};
struct SchedFFN : SchedBase {
    static constexpr int NT0 = KQ / 128;
    const char *AQ, *A, *Bt;
    __device__ __forceinline__ bool next(int i, pg8::Unit& u) const { const int L = i * G + c; if (L >= 64 * 86) return false; pg8::tile_of(L, 64, 86, u.pm, u.pn, 8); u.z = 0; return true; }
    __device__ __forceinline__ void ptrs(const pg8::Unit& u, const char*& a, const char*& b) const { a = AQ + (size_t)u.pm * 256 * D * 2; b = Bt + (size_t)u.pn * 256 * D * 2; }
    __device__ __forceinline__ void ptrs2(const pg8::Unit& u, const char*& a, const char*& b) const { a = A + (size_t)u.pm * 256 * D * 2 + KQ * 2; b = Bt + (size_t)u.pn * 256 * D * 2 + KQ * 2; }
};
struct SchedPitch : SchedBase {
    const char* A; const char* Bt; int nM, nN; size_t pa, pb; int wgm;
    __device__ __forceinline__ bool next(int i, pg8::Unit& u) const { const int L = i * G + c; if (L >= nM * nN) return false; pg8::tile_of(L, nM, nN, u.pm, u.pn, wgm); u.z = 0; return true; }
    __device__ __forceinline__ void ptrs(const pg8::Unit& u, const char*& a, const char*& b) const { a = A + (size_t)u.pm * pa; b = Bt + (size_t)u.pn * pb; }
};
struct SchedMix : SchedBase {
    const char *AG, *BG, *A0, *B0, *A1, *B1;
    __device__ __forceinline__ bool next(int i, pg8::Unit& u) const { const int L = i * G + c; if (L >= 64 * 16) return false; pg8::tile_of(L, 64, 16, u.pm, u.pn, 8); u.z = 0; return true; }
    __device__ __forceinline__ void ptrs(const pg8::Unit& u, const char*& a, const char*& b) const { a = AG + ((size_t)u.pm << 20); b = BG + ((size_t)(2 * u.pn) << 20); }
    __device__ __forceinline__ void ptrs_all(const pg8::Unit& u, const char*& g2b, const char*& fa, const char*& fb, const char*& ma, const char*& mb) const {
        g2b = BG + ((size_t)(2 * u.pn + 1) << 20); fa = A0 + ((size_t)u.pm << 20); fb = B0 + ((size_t)u.pn << 20); ma = A1 + ((size_t)u.pm << 20); mb = B1 + ((size_t)u.pn << 20); }
};
struct SchedFold : SchedBase {
    const bf16* A; const bf16* Bt;
    __device__ __forceinline__ bool next(int i, pg8::Unit& u) const { const int L = i * G + c; if (L >= 16 * 8) return false; u.pm = L & 15; u.pn = L >> 4; u.z = 0; return true; }
    __device__ __forceinline__ void ptrs(const pg8::Unit& u, const char*& a, const char*& b) const { a = (const char*)A + ((size_t)u.pm * 256 * D + (size_t)(u.pn >> 1) * 512) * 2; b = (const char*)Bt + (size_t)u.pn * 256 * 512 * 2; }
};

using pg8::f32x4; using pg8::u32x4;
__device__ __forceinline__ f32x4 i2f(const pg8::f32x4& v) { return __builtin_convertvector(__builtin_bit_cast(pg8::i32x4, v), pg8::f32x4); }
__device__ __forceinline__ u32x4 pack8(const pg8::f32x4& v0, const pg8::f32x4& v1) { u32x4 w; w.x = pg8::cvt_pk_bf16(v0[0], v0[1]); w.y = pg8::cvt_pk_bf16(v0[2], v0[3]); w.z = pg8::cvt_pk_bf16(v1[0], v1[1]); w.w = pg8::cvt_pk_bf16(v1[2], v1[3]); return w; }

template <bool INT>
struct EpiProj {
    static constexpr bool HAS_MID = false, PERM = true;
    bf16 *Q, *Kb, *Vb, *U; const float* rope; float unscale;
    __device__ __forceinline__ void operator()(const f32x4 (&acc)[2][2][4][2], const pg8::Unit& u, int wr, int wc, int fr, int fq) const {
        const int rbase = u.pm * 256 + wr * 64 + fr; const int pn = u.pn;
        if (pn >= 9) {
            bf16* base; int ldc, col0;
            if (pn == 9) { base = Vb; ldc = KVW; col0 = wc * 32 + 8 * fq; } else { base = U; ldc = PW; col0 = (pn - 10) * 256 + wc * 32 + 8 * fq; }
#pragma unroll
            for (int ai = 0; ai < 2; ++ai)
#pragma unroll
                for (int m = 0; m < 4; ++m) { bf16* rowp = base + (size_t)(rbase + ai * 128 + m * 16) * ldc + col0;
#pragma unroll
                    for (int bj = 0; bj < 2; ++bj) *(u32x4*)(rowp + bj * 128) = pack8((INT ? i2f(acc[ai][bj][m][0]) : acc[ai][bj][m][0]) * unscale, (INT ? i2f(acc[ai][bj][m][1]) : acc[ai][bj][m][1]) * unscale); }
        } else {
            bf16* base; int ldc, col0; float sc;
            if (pn < 8) { base = Q; ldc = AW; col0 = pn * 256 + wc * 32 + 8 * fq; sc = 0.125f; } else { base = Kb; ldc = KVW; col0 = wc * 32 + 8 * fq; sc = 1.0f; }
            const float us = unscale;
            const bool ropew = (wc & 1) == 0;
            const float sgn = (fq == 0) ? -1.0f : 1.0f;
#pragma unroll
            for (int ai = 0; ai < 2; ++ai)
#pragma unroll
                for (int m = 0; m < 4; ++m) { const int row = rbase + ai * 128 + m * 16; bf16* rowp = base + (size_t)row * ldc + col0;
                    f32x4 c0, c1, s0, s1;
                    if (ropew) { const int pos = row < M ? (row & (SEQ - 1)) + NMETA : row - M; const float* rp = rope + (size_t)pos * 16;
                        c0 = *(const f32x4*)(rp); c1 = *(const f32x4*)(rp + 4); s0 = *(const f32x4*)(rp + 8) * sgn; s1 = *(const f32x4*)(rp + 12) * sgn; }
#pragma unroll
                    for (int bj = 0; bj < 2; ++bj) { f32x4 v0 = (INT ? i2f(acc[ai][bj][m][0]) : acc[ai][bj][m][0]) * us, v1 = (INT ? i2f(acc[ai][bj][m][1]) : acc[ai][bj][m][1]) * us;
                        if (ropew) { f32x4 p0, p1;
#pragma unroll
                            for (int e = 0; e < 4; ++e) { p0[e] = __shfl_xor(v0[e], 16); p1[e] = __shfl_xor(v1[e], 16); }
                            const f32x4 r0 = v0 * c0 + p0 * s0, r1 = v1 * c1 + p1 * s1;
                            if (fq < 2) { v0 = r0; v1 = r1; } }
                        v0 = v0 * sc; v1 = v1 * sc;
                        *(u32x4*)(rowp + bj * 128) = pack8(v0, v1); } }
        }
    }
};
struct EpiFold {
    static constexpr bool HAS_MID = false, PERM = true;
    bf16* O;
    __device__ __forceinline__ void operator()(const f32x4 (&acc)[2][2][4][2], const pg8::Unit& u, int wr, int wc, int fr, int fq) const {
        const int row0 = u.pm * 256 + wr * 64 + fr, col0 = u.pn * 256 + wc * 32 + 8 * fq;
#pragma unroll
        for (int ai = 0; ai < 2; ++ai)
#pragma unroll
            for (int m = 0; m < 4; ++m) { bf16* rowp = O + (size_t)(row0 + ai * 128 + m * 16) * PW + col0;
#pragma unroll
                for (int bj = 0; bj < 2; ++bj) *(u32x4*)(rowp + bj * 128) = pack8(acc[ai][bj][m][0], acc[ai][bj][m][1]); }
    }
};
__device__ __forceinline__ void mul8(f32x4& v0, f32x4& v1, const u32x4& gw) {
    v0[0] *= pg8::bf_lo(gw.x); v0[1] *= pg8::bf_hi(gw.x); v0[2] *= pg8::bf_lo(gw.y); v0[3] *= pg8::bf_hi(gw.y);
    v1[0] *= pg8::bf_lo(gw.z); v1[1] *= pg8::bf_hi(gw.z); v1[2] *= pg8::bf_lo(gw.w); v1[3] *= pg8::bf_hi(gw.w); }
struct EpiMixF {
    static constexpr bool HAS_MID = true, PERM = true; static constexpr int NST = 16;
    const float* bgate; u32x4* slab; bf16* MIXED;
    __device__ __forceinline__ void gate(const f32x4 (&acc)[2][2][4][2], const pg8::Unit& u, int j, int wr, int wc, int fr, int fq) const {
        asm volatile("" : "+v"(fr), "+v"(fq));
        const int ch0 = (2 * u.pn + j) * 128 + wc * 32 + 8 * fq;
        u32x4* sl = slab + (wr * 4 + wc) * 64 + fq * 16 + fr;
        f32x4 bA[2], bB[2];
#pragma unroll
        for (int n = 0; n < 2; ++n) { bA[n] = *(const f32x4*)(bgate + ch0 + 4 * n); bB[n] = *(const f32x4*)(bgate + D + ch0 + 4 * n); }
#pragma unroll
        for (int ai = 0; ai < 2; ++ai)
#pragma unroll
            for (int m = 0; m < 4; ++m) {
                f32x4 a0 = i2f(acc[ai][0][m][0]) * G8_UNSCALE + bA[0], a1 = i2f(acc[ai][0][m][1]) * G8_UNSCALE + bA[1], b0 = i2f(acc[ai][1][m][0]) * G8_UNSCALE + bB[0], b1 = i2f(acc[ai][1][m][1]) * G8_UNSCALE + bB[1];
#pragma unroll
                for (int e = 0; e < 4; ++e) {
                    const float xa0 = __builtin_amdgcn_fmed3f(a0[e], -30.f, 30.f), xb0 = __builtin_amdgcn_fmed3f(b0[e], -30.f, 30.f), xa1 = __builtin_amdgcn_fmed3f(a1[e], -30.f, 30.f), xb1 = __builtin_amdgcn_fmed3f(b1[e], -30.f, 30.f);
                    const float ea0 = 1.0f + __builtin_amdgcn_exp2f(-1.44269504f * xa0), eb0 = 1.0f + __builtin_amdgcn_exp2f(-1.44269504f * xb0);
                    const float ea1 = 1.0f + __builtin_amdgcn_exp2f(-1.44269504f * xa1), eb1 = 1.0f + __builtin_amdgcn_exp2f(-1.44269504f * xb1);
                    a0[e] = eb0 * __builtin_amdgcn_rcpf(ea0); b0[e] = __builtin_amdgcn_rcpf(eb0); a1[e] = eb1 * __builtin_amdgcn_rcpf(ea1); b1[e] = __builtin_amdgcn_rcpf(eb1); }
                sl[((j * 2 + 0) * 8 + ai * 4 + m) * 512] = pack8(a0, a1); sl[((j * 2 + 1) * 8 + ai * 4 + m) * 512] = pack8(b0, b1); }
    }
    __device__ __forceinline__ void mid(f32x4 (&acc)[2][2][4][2], const pg8::Unit& u, int wr, int wc, int fr, int fq) const {
        asm volatile("" : "+v"(fr), "+v"(fq));
        const u32x4* sl = slab + (wr * 4 + wc) * 64 + fq * 16 + fr;
#pragma unroll
        for (int ai = 0; ai < 2; ++ai)
#pragma unroll
            for (int m = 0; m < 4; ++m)
#pragma unroll
                for (int bj = 0; bj < 2; ++bj) { const u32x4 gw = sl[((bj * 2 + 0) * 8 + ai * 4 + m) * 512];
                    f32x4 v0 = i2f(acc[ai][bj][m][0]) * AU8_UNSCALE, v1 = i2f(acc[ai][bj][m][1]) * AU8_UNSCALE; mul8(v0, v1, gw);
                    acc[ai][bj][m][0] = v0; acc[ai][bj][m][1] = v1; }
    }
    __device__ __forceinline__ void operator()(const f32x4 (&acc)[2][2][4][2], const pg8::Unit& u, int wr, int wc, int fr, int fq) const {
        asm volatile("" : "+v"(fr), "+v"(fq));
        const int row0 = u.pm * 256 + wr * 64 + fr, col0 = u.pn * 256 + wc * 32 + 8 * fq;
        const u32x4* sl = slab + (wr * 4 + wc) * 64 + fq * 16 + fr;
        u32x4 gwv[2][4][2];
#pragma unroll
        for (int ai = 0; ai < 2; ++ai)
#pragma unroll
            for (int m = 0; m < 4; ++m)
#pragma unroll
                for (int bj = 0; bj < 2; ++bj) gwv[ai][m][bj] = sl[((bj * 2 + 1) * 8 + ai * 4 + m) * 512];
#pragma unroll
        for (int ai = 0; ai < 2; ++ai)
#pragma unroll
            for (int m = 0; m < 4; ++m) { const size_t off = (size_t)(row0 + ai * 128 + m * 16) * D + col0;
#pragma unroll
                for (int bj = 0; bj < 2; ++bj) {
                    f32x4 v0 = acc[ai][bj][m][0], v1 = acc[ai][bj][m][1]; mul8(v0, v1, gwv[ai][m][bj]);
                    *(u32x4*)(MIXED + off + bj * 128) = pack8(v0, v1); } }
    }
};
template <bool OUTF>
struct EpiResidXLN {
    static constexpr bool HAS_MID = false, PERM = true;
    const bf16* Xb; const unsigned char* Xlo; int lo_pitch, lo_off;
    unsigned long long* xs; gu32* cnt; gu32* tmo; LAS unsigned char* lt;
    float* outf; bf16* outb; const float* g2; const float* b2; unsigned char* outq;
    __device__ __forceinline__ void operator()(f32x4 (&v)[2][2][4][2], const pg8::Unit& u, int wr, int wc, int fr, int fq) const {
        asm volatile("" : "+v"(fr), "+v"(fq));
        typedef float f32x2v __attribute__((ext_vector_type(2)));
        LAS f32x2v* P = (LAS f32x2v*)lt;
        LAS f32x2v* S = (LAS f32x2v*)(lt + 8192);
        LAS unsigned* flag = (LAS unsigned*)(lt + 8192 + 2048);
        const int lane = fq * 16 + fr, wid = wr * 4 + wc;
        const int row0 = u.pm * 256 + wr * 64 + fr, col0 = u.pn * 256 + wc * 32 + 8 * fq;
        {
#pragma unroll
            for (int ai = 0; ai < 2; ++ai)
#pragma unroll
                for (int m = 0; m < 4; ++m) { const size_t off = (size_t)(row0 + ai * 128 + m * 16) * D + col0;
#pragma unroll
                    for (int bj = 0; bj < 2; ++bj) { const u32x4 xw = *(const u32x4*)(Xb + off + bj * 128);
                        f32x4 r0, r1;
                        if constexpr (OUTF) { r0[0] = q12_lo(xw.x); r0[1] = q12_hi(xw.x); r0[2] = q12_lo(xw.y); r0[3] = q12_hi(xw.y); r1[0] = q12_lo(xw.z); r1[1] = q12_hi(xw.z); r1[2] = q12_lo(xw.w); r1[3] = q12_hi(xw.w); }
                        else { r0[0] = pg8::bf_lo(xw.x); r0[1] = pg8::bf_hi(xw.x); r0[2] = pg8::bf_lo(xw.y); r0[3] = pg8::bf_hi(xw.y); r1[0] = pg8::bf_lo(xw.z); r1[1] = pg8::bf_hi(xw.z); r1[2] = pg8::bf_lo(xw.w); r1[3] = pg8::bf_hi(xw.w);
                            const v2u lw = *(const v2u*)(Xlo + (size_t)(row0 + ai * 128 + m * 16) * lo_pitch + lo_off + col0 + bj * 128);
#pragma unroll
                            for (int e = 0; e < 4; ++e) { r0[e] += sb(lw.x, e) * ulp254(r0[e]); r1[e] += sb(lw.y, e) * ulp254(r1[e]); } }
                        v[ai][bj][m][0] = r0 * DN_ALPHA + v[ai][bj][m][0]; v[ai][bj][m][1] = r1 * DN_ALPHA + v[ai][bj][m][1]; }
                    asm volatile("" : "+v"(v[ai][0][m][0]), "+v"(v[ai][0][m][1]), "+v"(v[ai][1][m][0]), "+v"(v[ai][1][m][1]));
                    if (m == 3) asm volatile("" ::: "memory"); }
        }
#pragma unroll
        for (int ai = 0; ai < 2; ++ai)
#pragma unroll
            for (int m = 0; m < 4; ++m) {
                float s = 0.f;
#pragma unroll
                for (int bj = 0; bj < 2; ++bj)
#pragma unroll
                    for (int n = 0; n < 2; ++n) { const f32x4 x = v[ai][bj][m][n]; s += (x[0] + x[1]) + (x[2] + x[3]); }
                s += __shfl_xor(s, 16); s += __shfl_xor(s, 32);
                const float mw = s * (1.0f / 64.0f); float q = 0.f;
#pragma unroll
                for (int bj = 0; bj < 2; ++bj)
#pragma unroll
                    for (int n = 0; n < 2; ++n) { const f32x4 d = v[ai][bj][m][n] - mw; q += (d[0] * d[0] + d[1] * d[1]) + (d[2] * d[2] + d[3] * d[3]); }
                q += __shfl_xor(q, 16); q += __shfl_xor(q, 32);
                if (fq == 0) P[(ai * 128 + wr * 64 + m * 16 + fr) * 4 + wc] = (f32x2v){mw, q};
            }
        asm volatile("s_waitcnt lgkmcnt(0)" ::: "memory"); __builtin_amdgcn_s_barrier(); asm volatile("" ::: "memory");
        const int row = wid * 32 + (lane & 31);
        if (lane < 32) {
            const f32x2v a = P[row * 4 + 0], bq = P[row * 4 + 1], c = P[row * 4 + 2], d = P[row * 4 + 3];
            const float mt = (a.x + bq.x + c.x + d.x) * 0.25f;
            const float da = a.x - mt, db = bq.x - mt, dc = c.x - mt, dd = d.x - mt;
            const float m2 = (a.y + bq.y) + (c.y + d.y) + 64.0f * ((da * da + db * db) + (dc * dc + dd * dd));
            unsigned long long* slot = xs + ((size_t)(u.pm * 256 + row) * 16 + u.pn);
            __hip_atomic_store(slot, ((unsigned long long)__float_as_uint(m2) << 32) | __float_as_uint(mt), __ATOMIC_RELAXED, __HIP_MEMORY_SCOPE_AGENT);
        }
        asm volatile("s_waitcnt vmcnt(0)" ::: "memory");
        gu32* cw = cnt + 64 * u.pm;
        if (lane == 0) __hip_atomic_fetch_add(cw, 1u, __ATOMIC_RELAXED, __HIP_MEMORY_SCOPE_AGENT);
        if (wid == 0) {
            bool dead = false; unsigned sp = 0;
            while ((unsigned)__builtin_amdgcn_readfirstlane((int)__hip_atomic_load(cw, __ATOMIC_RELAXED, __HIP_MEMORY_SCOPE_AGENT)) < 128u) {
                __builtin_amdgcn_s_sleep(1);
                if ((++sp & 255u) == 0u) { if (__builtin_amdgcn_readfirstlane((int)__hip_atomic_load(tmo, __ATOMIC_RELAXED, __HIP_MEMORY_SCOPE_AGENT))) { dead = true; break; }
                    if (sp > (1u << 20)) { if (lane == 0) __hip_atomic_store(tmo, 1u, __ATOMIC_RELAXED, __HIP_MEMORY_SCOPE_AGENT); dead = true; break; } } }
            __builtin_amdgcn_fence(__ATOMIC_ACQUIRE, "agent");
            if (lane == 0) flag[0] = dead ? 1u : 0u;
        }
        asm volatile("s_waitcnt vmcnt(0) lgkmcnt(0)" ::: "memory"); __builtin_amdgcn_s_barrier(); asm volatile("" ::: "memory");
        const bool bad = flag[0] != 0u;
        if (lane < 32) {
            const unsigned long long* slot = xs + (size_t)(u.pm * 256 + row) * 16; float mt[16], m2[16]; float ms = 0.f;
#pragma unroll
            for (int t = 0; t < 16; ++t) { const unsigned long long w = __hip_atomic_load(slot + t, __ATOMIC_RELAXED, __HIP_MEMORY_SCOPE_AGENT); mt[t] = __uint_as_float((unsigned)w); m2[t] = __uint_as_float((unsigned)(w >> 32)); ms += mt[t]; }
            const float mean = ms * (1.0f / 16.0f); float q = 0.f;
#pragma unroll
            for (int t = 0; t < 16; ++t) { const float dm = mt[t] - mean; q += m2[t] + 256.0f * dm * dm; }
            S[row] = (f32x2v){mean, 1.0f / sqrtf(q * (1.0f / (float)D) + LN_EPS)};
        }
        asm volatile("s_waitcnt lgkmcnt(0)" ::: "memory"); __builtin_amdgcn_s_barrier(); asm volatile("" ::: "memory");
        f32x4 g2v[2][2], b2v[2][2];
#pragma unroll
        for (int bj = 0; bj < 2; ++bj)
#pragma unroll
            for (int n = 0; n < 2; ++n) { g2v[bj][n] = *(const f32x4*)(g2 + col0 + bj * 128 + n * 4); b2v[bj][n] = *(const f32x4*)(b2 + col0 + bj * 128 + n * 4); }
        const float qnan = __builtin_nanf("");
#pragma unroll
        for (int ai = 0; ai < 2; ++ai)
#pragma unroll
            for (int m = 0; m < 4; ++m) { const int r = ai * 128 + wr * 64 + m * 16 + fr; f32x2v sr = S[r]; if (bad) sr.y = qnan; const size_t off = (size_t)(u.pm * 256 + r) * D + col0;
#pragma unroll
                for (int bj = 0; bj < 2; ++bj) { const f32x4 o0 = (v[ai][bj][m][0] - sr.x) * sr.y * g2v[bj][0] + b2v[bj][0], o1 = (v[ai][bj][m][1] - sr.x) * sr.y * g2v[bj][1] + b2v[bj][1];
                    if (OUTF) { *(f32x4*)(outf + off + bj * 128) = o0; *(f32x4*)(outf + off + bj * 128 + 4) = o1; }
                    else { u32x4 w; w.x = pk2_q12(o0[0], o0[1]); w.y = pk2_q12(o0[2], o0[3]); w.z = pk2_q12(o1[0], o1[1]); w.w = pk2_q12(o1[2], o1[3]); *(u32x4*)(outb + off + bj * 128) = w;
                        if (u.pn < KQ / 256) { v2u q; q.x = pk4_fp8(o0[0] * H8_SCALE, o0[1] * H8_SCALE, o0[2] * H8_SCALE, o0[3] * H8_SCALE); q.y = pk4_fp8(o1[0] * H8_SCALE, o1[1] * H8_SCALE, o1[2] * H8_SCALE, o1[3] * H8_SCALE);
                            *(v2u*)(outq + (size_t)(u.pm * 256 + r) * (D * 2) + col0 + bj * 128) = q; } } } }
    }
};
template <bool INT>
struct EpiSwiglu {
    static constexpr bool HAS_MID = true, PERM = true;
    bf16* O;
    __device__ __forceinline__ void mid(f32x4 (&acc)[2][2][4][2], const pg8::Unit& u, int wr, int wc, int fr, int fq) const {
#pragma unroll
        for (int ai = 0; ai < 2; ++ai)
#pragma unroll
            for (int bj = 0; bj < 2; ++bj)
#pragma unroll
                for (int m = 0; m < 4; ++m)
#pragma unroll
                    for (int n = 0; n < 2; ++n) acc[ai][bj][m][n] = i2f(acc[ai][bj][m][n]) * G8_UNSCALE;
    }
    __device__ __forceinline__ void operator()(const f32x4 (&acc)[2][2][4][2], const pg8::Unit& u, int wr, int wc, int fr, int fq) const {
        const int row0 = u.pm * 256 + wr * 64 + fr, col0 = u.pn * 128 + wc * 32 + 8 * fq;
#pragma unroll
        for (int ai = 0; ai < 2; ++ai)
#pragma unroll
            for (int m = 0; m < 4; ++m) { f32x4 v0, v1;
                const f32x4 ga = INT ? i2f(acc[ai][0][m][0]) * G8_UNSCALE : acc[ai][0][m][0], gb = INT ? i2f(acc[ai][0][m][1]) * G8_UNSCALE : acc[ai][0][m][1];
                const f32x4 ua = INT ? i2f(acc[ai][1][m][0]) * G8_UNSCALE : acc[ai][1][m][0], ub = INT ? i2f(acc[ai][1][m][1]) * G8_UNSCALE : acc[ai][1][m][1];
#pragma unroll
                for (int e = 0; e < 4; ++e) { v0[e] = ga[e] * pg8::sigmoidf_fast(ga[e]) * ua[e]; v1[e] = gb[e] * pg8::sigmoidf_fast(gb[e]) * ub[e]; }
                *(u32x4*)(O + (size_t)(row0 + ai * 128 + m * 16) * FF + col0) = pack8(v0, v1); }
    }
};

__global__ void __launch_bounds__(NWAVES * 64, 2) fwd_kernel(Args args) {
    extern __shared__ __attribute__((aligned(16))) unsigned char lds[];
    Frame F;
    F.lds = (LAS unsigned char*)lds;
    F.MISC = (volatile LAS unsigned*)(F.lds + MISC_OFF);
    F.tid = threadIdx.x; F.lane = F.tid & 63; F.wave = __builtin_amdgcn_readfirstlane(F.tid >> 6);
    F.G = gridDim.x;
    unsigned char* ws = args.ws;
    F.ctl = (gu32*)(ws + WS_CTL);
    for (int u = F.tid; u < (LDS_BYTES - LDSCTL_OFF) / 4; u += NWAVES * 64) ((LAS unsigned*)(F.lds + LDSCTL_OFF))[u] = 0u;
    __syncthreads();
    XcdBarrier bar = xcd_barrier_post((unsigned*)(F.ctl + CW_BAR), F.MISC + 8);

    const float* x = args.in[0]; const float* meta = args.in[1]; const float* ln_in_g = args.in[2]; const float* ln_in_b = args.in[3];
    const float* w_in = args.in[4]; const float* b_gate = args.in[5]; const float* sinks = args.in[6]; const float* w_attn_up = args.in[7];
    const float* w_pool_grp = args.in[8]; const float* pool_scale = args.in[9]; const float* w_pool_up = args.in[10]; const float* w_out = args.in[11];
    const float* ln1_g = args.in[12]; const float* ln1_b = args.in[13]; const float* w_ffn_in = args.in[14]; const float* w_ffn_down = args.in[15];
    const float* ln2_g = args.in[16]; const float* ln2_b = args.in[17];
    float* out = args.out;
    float* ROPE = (float*)(ws + WS_ROPE);
    bf16 *WIN = (bf16*)(ws + WS_WIN), *WAU = (bf16*)(ws + WS_WAU), *WPG = (bf16*)(ws + WS_WPG), *WOUT = (bf16*)(ws + WS_WOUT), *WFFI = (bf16*)(ws + WS_WFFI), *WFFD = (bf16*)(ws + WS_WFFD);
    unsigned char *H8 = ws + WS_H8, *WG8 = ws + WS_WG8, *W8P = ws + WS_W8P, *ATT8 = ws + WS_ATT8, *W8AU = ws + WS_W8AU;
    bf16 *H = (bf16*)(ws + WS_H), *QB = (bf16*)(ws + WS_Q), *KB = (bf16*)(ws + WS_K), *VB = (bf16*)(ws + WS_V), *UB = (bf16*)(ws + WS_U);
    bf16 *WPT = (bf16*)(ws + WS_WPT), *POOLED = (bf16*)(ws + WS_POOLED), *MIXED = (bf16*)(ws + WS_MIXED), *H1 = (bf16*)(ws + WS_H1), *ACT = (bf16*)(ws + WS_ACT);
    const int gw = blockIdx.x * NWAVES + F.wave, NGW = F.G * NWAVES;

    {
        LAS float* scr = (LAS float*)(F.lds + RING_OFF + F.wave * 16384);
#pragma unroll 1
        for (int pass = 0; pass < 2; ++pass) {
            if (((pass ^ F.wave) & 1) == 0) { P0Src S{gw, NGW, w_in, w_attn_up, w_pool_up, w_pool_grp, w_out, w_ffn_in, WIN, WAU, WPG, WOUT, WFFI, WG8, W8P, W8AU, -1, 0}; run_pairs<P0Src, false>(S, scr, F.lane); }
            else for (int m = gw; m < M; m += NGW) ln_row(x + (size_t)m * D, H + (size_t)m * D, H8 + (size_t)m * D, ws + WS_HLO + (size_t)m * D, ln_in_g, ln_in_b, F.lane);
        }
        for (int m = gw; m < 256; m += NGW) {
            if (m < NMETA) ln_row(meta + (size_t)m * D, H + (size_t)(M + m) * D, H8 + (size_t)(M + m) * D, ws + WS_HLO + (size_t)(M + m) * D, ln_in_g, ln_in_b, F.lane);
            else { v2u z; z.x = 0u; z.y = 0u;
#pragma unroll
                for (int j = 0; j < 16; ++j) { ((v2u*)(H + (size_t)(M + m) * D))[F.lane + 64 * j] = z; ((unsigned*)(H8 + (size_t)(M + m) * D))[F.lane + 64 * j] = 0u; } }
        }
        for (int idx = blockIdx.x * 512 + F.tid; idx < 4 * 512 * 512 / 8; idx += F.G * 512) { const int d0 = (idx & 63) * 8, g = idx >> 15;
            const f32x4 w0 = *(const f32x4*)(w_pool_grp + (size_t)idx * 8), w1 = *(const f32x4*)(w_pool_grp + (size_t)idx * 8 + 4);
            const f32x4 s0 = *(const f32x4*)(pool_scale + g * 512 + d0), s1 = *(const f32x4*)(pool_scale + g * 512 + d0 + 4);
            v4u o; o.x = pk2(w0.x * s0.x, w0.y * s0.y); o.y = pk2(w0.z * s0.z, w0.w * s0.w); o.z = pk2(w1.x * s1.x, w1.y * s1.y); o.w = pk2(w1.z * s1.z, w1.w * s1.w);
            *(v4u*)(WPG + (size_t)idx * 8) = o; }
        for (int idx = blockIdx.x * 512 + F.tid; idx < NPOS * 8; idx += F.G * 512) { const int pos = idx >> 3, i = idx & 7;
            const float invf = __builtin_amdgcn_exp2f(-(float)i * 0.125f * 18.931568569324174f);
            const float ang = (float)pos * invf; float sn, cs; sincos_d(ang, sn, cs);
            ROPE[pos * 16 + i] = cs; ROPE[pos * 16 + 8 + i] = sn; }
    }
    xcd_barrier(bar);

    {
        pg8::Gemm g{D / 2, D / 2, D / 2}; SchedF8 S; S.G = F.G; S.c = (int)blockIdx.x; S.A = H8; S.BP = W8P;
        EpiProj<true> E{QB, KB, VB, UB, ROPE, G8_UNSCALE};
        pg8::gemm_phase<EpiProj<true>, SchedF8, PG8_ALIGN, false, true>(F.lds + RING_OFF, g, S, E);
    }
    {
        pg8::Gemm g{D, D, D}; SchedProj S; S.G = F.G; S.c = (int)blockIdx.x; S.A = H; S.Bt = WIN;
        EpiProj<false> E{QB, KB, VB, UB, ROPE, 1.0f};
        pg8::gemm_phase<EpiProj<false>, SchedProj, PG8_ALIGN, PG8_SP2>(F.lds + RING_OFF, g, S, E);
    }
    {
        pg8::Gemm g{512, D, 512}; SchedFold S; S.G = F.G; S.c = ((int)blockIdx.x + 118) & 255; S.A = WAU + AW; S.Bt = WPG;
        EpiFold E{WPT};
        pg8::gemm_phase<EpiFold, SchedFold, PG8_ALIGN, PG8_SP2>(F.lds + RING_OFF, g, S, E);
    }
    if ((int)blockIdx.x >= 138) {
        QueueSrc Q{F.ctl + CW_Q2, w_ffn_down, WFFD, FF, D, 0, F.lane, 4}; run_pairs<QueueSrc, true>(Q, (LAS float*)(F.lds + RING_OFF + F.wave * 16384), F.lane);
    }
    xcd_barrier(bar);

    {
        LAS unsigned char* Ks = F.lds + RING_OFF; LAS unsigned char* Vs = F.lds + RING_OFF + 224 * 144;
        v4u pk[4], pv[4];
        auto stage_load = [&](int unit) {
            const int tb = unit & 63, kh = (unit >> 6) & 3, b = unit >> 8, t0 = tb * 64;
#pragma unroll
            for (int k = 0; k < 4; ++k) { const int c = F.tid + 512 * k; const int kr = c >> 3, ch = c & 7; int srow = 0; bool ok = c < 224 * 8;
                if (kr < 192) { const int t = t0 - 128 + kr; ok = ok && t >= 0; srow = b * SEQ + t; } else if (kr < 208) srow = M + (kr - 192); else ok = false;
                pk[k] = (v4u){0u, 0u, 0u, 0u}; pv[k] = (v4u){0u, 0u, 0u, 0u};
                if (ok) { pk[k] = *(const v4u*)(KB + (size_t)srow * KVW + kh * 64 + ch * 8); pv[k] = *(const v4u*)(VB + (size_t)srow * KVW + kh * 64 + ch * 8); } } };
        auto stage_store = [&]() {
#pragma unroll
            for (int k = 0; k < 4; ++k) { const int c = F.tid + 512 * k; const int kr = c >> 3, ch = c & 7;
                if (c < 224 * 8) { *(LAS v4u*)(Ks + kr * 144 + ch * 16) = pk[k]; *(LAS v4u*)(Vs + kr * 144 + ch * 16) = pv[k]; } } };
        if ((int)blockIdx.x < 1024) { stage_load(blockIdx.x); stage_store(); }
        __syncthreads();
        for (int unit = blockIdx.x; unit < 1024; unit += F.G) {
            const int tb = unit & 63, kh = (unit >> 6) & 3, b = unit >> 8, t0 = tb * 64;
            const bool has_next = unit + F.G < 1024;
            if (has_next) stage_load(unit + F.G);
            const int hq = kh * 8 + F.wave; const float sink2 = sinks[hq] * 1.44269504f;
            const int r = F.lane & 31, h = F.lane >> 5, g4 = F.lane >> 4, gi = F.lane & 15;
            const int blk_min = t0 < 128 ? ((128 - t0) >> 5) : 0;
            const LAS unsigned char* kbase = Ks + r * 144 + 16 * h;
            const LAS unsigned char* vbase = Vs + (4 * h + (gi >> 2)) * 144 + (16 * (g4 & 1) + 4 * (gi & 3)) * 2;
#pragma unroll 1
            for (int qg = 0; qg < 2; ++qg) {
                const bf16* qrow = QB + (size_t)(b * SEQ + t0 + 32 * qg + r) * AW + hq * 64 + 8 * h;
                pg8::bf16x8 qf[4];
#pragma unroll
                for (int s = 0; s < 4; ++s) qf[s] = *(const pg8::bf16x8*)(qrow + 16 * s);
                f32x16 sc[6];
#pragma unroll
                for (int kb = 0; kb < 6; ++kb) { const int rowbase = kb < 5 ? 32 * (qg + kb) : 192; f32x16 a = {};
#pragma unroll
                    for (int s = 0; s < 4; ++s) { const pg8::bf16x8 kf = *(const LAS pg8::bf16x8*)(kbase + rowbase * 144 + 32 * s); a = __builtin_amdgcn_mfma_f32_32x32x16_bf16(kf, qf[s], a, 0, 0, 0); }
                    sc[kb] = a; }
                float mx = sink2;
                int rr = r - 4 * h; asm volatile("" : "+v"(rr));
#pragma unroll
                for (int kb = 0; kb < 6; ++kb)
#pragma unroll
                    for (int e = 0; e < 16; ++e) { bool valid;
                        const int rk0 = (e & 3) + 8 * (e >> 2);
                        if (kb == 0) valid = rk0 > rr; else if (kb == 4) valid = rk0 <= rr; else if (kb == 5) valid = e < 8  ; else valid = true;
                        if (kb < 5) valid = valid && (qg + kb >= blk_min);
                        const float v = valid ? sc[kb][e] * 1.44269504f : -1e30f; sc[kb][e] = v; mx = fmaxf(mx, v); }
                mx = fmaxf(mx, __shfl_xor(mx, 32));
                float l = 0.f;
#pragma unroll
                for (int kb = 0; kb < 6; ++kb)
#pragma unroll
                    for (int e = 0; e < 16; ++e) { const float p = __builtin_amdgcn_exp2f(sc[kb][e] - mx); sc[kb][e] = p; l += p; }
                l += __shfl_xor(l, 32); l += __builtin_amdgcn_exp2f(sink2 - mx);
                f32x16 o0 = {}, o1 = {};
#pragma unroll
                for (int kb = 0; kb < 6; ++kb) { const int rowbase = kb < 5 ? 32 * (qg + kb) : 192;
#pragma unroll
                    for (int s2 = 0; s2 < 2; ++s2) {
                        pg8::bf16x8 pf; { const unsigned w0 = pg8::cvt_pk_bf16(sc[kb][8 * s2 + 0], sc[kb][8 * s2 + 1]), w1 = pg8::cvt_pk_bf16(sc[kb][8 * s2 + 2], sc[kb][8 * s2 + 3]), w2 = pg8::cvt_pk_bf16(sc[kb][8 * s2 + 4], sc[kb][8 * s2 + 5]), w3 = pg8::cvt_pk_bf16(sc[kb][8 * s2 + 6], sc[kb][8 * s2 + 7]);
                            const u32x4 pw = {w0, w1, w2, w3}; pf = __builtin_bit_cast(pg8::bf16x8, pw); }
                        const LAS unsigned char* vp = vbase + (rowbase + 16 * s2) * 144;
                        const s16x4 a0 = vtr(vp), a1 = vtr(vp + 8 * 144), c0 = vtr(vp + 64), c1 = vtr(vp + 8 * 144 + 64);
                        const pg8::bf16x8 vf0 = {a0[0], a0[1], a0[2], a0[3], a1[0], a1[1], a1[2], a1[3]}, vf1 = {c0[0], c0[1], c0[2], c0[3], c1[0], c1[1], c1[2], c1[3]};
                        o0 = __builtin_amdgcn_mfma_f32_32x32x16_bf16(vf0, pf, o0, 0, 0, 0);
                        o1 = __builtin_amdgcn_mfma_f32_32x32x16_bf16(vf1, pf, o1, 0, 0, 0); } }
                const float inv = 1.0f / l;
                unsigned char* orow = ATT8 + (size_t)(b * SEQ + t0 + 32 * qg + r) * (2 * AW) + hq * 64 + 4 * h;
                const float inv8 = inv * ATT8_SCALE;
#pragma unroll
                for (int rq = 0; rq < 4; ++rq) {
                    *(unsigned*)(orow + 8 * rq) = pk4_fp8(o0[4 * rq + 0] * inv8, o0[4 * rq + 1] * inv8, o0[4 * rq + 2] * inv8, o0[4 * rq + 3] * inv8);
                    *(unsigned*)(orow + 32 + 8 * rq) = pk4_fp8(o1[4 * rq + 0] * inv8, o1[4 * rq + 1] * inv8, o1[4 * rq + 2] * inv8, o1[4 * rq + 3] * inv8); }
            }
            __syncthreads();
            if (has_next) { stage_store(); __syncthreads(); }
        }
        for (int task = gw; task < 2048; task += NGW) { const int g = task & 3, run = (task >> 2) & 127, b = task >> 9;
            if (g == 0) pool_task<2>(UB, POOLED, b, run, 0, F.lane); else if (g == 1) pool_task<4>(UB, POOLED, b, run, 1, F.lane);
            else if (g == 2) pool_task<8>(UB, POOLED, b, run, 2, F.lane); else pool_task<16>(UB, POOLED, b, run, 3, F.lane); }
    }
    xcd_barrier(bar);

    {
        pg8::Gemm g{PW, PW, PW}; SchedMix S; S.G = F.G; S.c = (int)blockIdx.x; S.AG = (const char*)H8; S.BG = (const char*)WG8; S.A0 = (const char*)ATT8; S.B0 = (const char*)W8AU; S.A1 = (const char*)POOLED; S.B1 = (const char*)WPT;
        EpiMixF E{b_gate, (u32x4*)(ws + WS_GSLAB) + (size_t)blockIdx.x * (32 * 512), MIXED};
        pg8::gemm_phase<EpiMixF, SchedMix, PG8_ALIGN, true, false, 1>(F.lds + RING_OFF, g, S, E);
    }
    xcd_barrier(bar);

    {
        pg8::Gemm g{D, D, D}; SchedXLN S; S.G = F.G; S.c = (int)blockIdx.x; S.A = MIXED; S.Bt = WOUT; S.K = D;
        EpiResidXLN<false> E{H, ws + WS_HLO, D, 0, (unsigned long long*)(ws + WS_XS1), F.ctl + CW_PAN1, F.ctl + CW_TMO2, F.lds + LDSCTL_OFF + 1024, nullptr, H1, ln1_g, ln1_b, ws + WS_H1Q};
        pg8::gemm_phase<EpiResidXLN<false>, SchedXLN, PG8_ALIGN, PG8_SP2>(F.lds + RING_OFF, g, S, E);
    }
    xcd_barrier(bar);

    {
        pg8::Gemm g{D / 2, D, D}; SchedFFN S; S.G = F.G; S.c = (int)blockIdx.x; S.AQ = (const char*)(ws + WS_H1Q); S.A = (const char*)H1; S.Bt = (const char*)WFFI;
        EpiSwiglu<true> E{ACT};
        pg8::gemm_phase<EpiSwiglu<true>, SchedFFN, PG8_ALIGN, true, true>(F.lds + RING_OFF, g, S, E);
        { QueueSrc Q{F.ctl + CW_Q2, w_ffn_down, WFFD, FF, D, 0, F.lane, 1 << 30}; run_pairs<QueueSrc, true>(Q, (LAS float*)(F.lds + RING_OFF + F.wave * 16384), F.lane); }
    }
    xcd_barrier(bar);

    {
        if (blockIdx.x == 0 && F.tid == 0 && xb_ld((unsigned*)(F.ctl + CW_BAR) + XB_TMO) != 0u) __hip_atomic_store(F.ctl + CW_TMO2, 1u, RLX_AGENT);
        pg8::Gemm g{FF, FF, FF}; SchedXLN S; S.G = F.G; S.c = (int)blockIdx.x; S.A = ACT; S.Bt = WFFD; S.K = FF;
        EpiResidXLN<true> E{H1, nullptr, 0, 0, (unsigned long long*)(ws + WS_XS2), F.ctl + CW_PAN2, F.ctl + CW_TMO2, F.lds + LDSCTL_OFF + 1024, out, nullptr, ln2_g, ln2_b, nullptr};
        pg8::gemm_phase<EpiResidXLN<true>, SchedXLN, PG8_ALIGN, PG8_SP2>(F.lds + RING_OFF, g, S, E);
    }
}

extern "C" void kernel_launch(void* const* d_in, const int* in_sizes, int n_in, void* d_out, int out_size, void* d_ws, size_t ws_size, hipStream_t stream) {
    static int grid = 0;
    if (grid == 0) {
        if (n_in != 18 || in_sizes[0] != M * D || out_size != M * D || ws_size < WS_END) { fprintf(stderr, "kernel_launch: unexpected shapes (n_in %d, in0 %d, out %d, ws %zu); nothing launched\n", n_in, n_in > 0 ? in_sizes[0] : -1, out_size, ws_size); grid = -1; return; }
        int dev = 0, cus = 0, per_cu = 0;
        if (hipGetDevice(&dev) != hipSuccess || hipDeviceGetAttribute(&cus, hipDeviceAttributeMultiprocessorCount, dev) != hipSuccess) { fprintf(stderr, "kernel_launch: device query failed\n"); grid = -1; return; }
        if (hipFuncSetAttribute((const void*)fwd_kernel, hipFuncAttributeMaxDynamicSharedMemorySize, LDS_BYTES) != hipSuccess) { fprintf(stderr, "kernel_launch: hipFuncSetAttribute failed\n"); grid = -1; return; }
        if (hipOccupancyMaxActiveBlocksPerMultiprocessor(&per_cu, (const void*)fwd_kernel, NWAVES * 64, LDS_BYTES) != hipSuccess || per_cu < 1)
            fprintf(stderr, "kernel_launch: note: occupancy query reports %d workgroups per CU\n", per_cu);
        (void)hipGetLastError();
        if (cus != 256) { fprintf(stderr, "kernel_launch: built for a 256-CU device (the in-phase LayerNorm needs one 256x256 tile per workgroup and round); found %d; nothing launched\n", cus); grid = -1; return; }
        grid = cus;
    }
    if (grid < 0) return;
    if (hipMemsetAsync((char*)d_ws + WS_CTL, 0, CTL_ZERO_BYTES, stream) != hipSuccess) { fprintf(stderr, "kernel_launch: memset failed\n"); return; }
    Args a{};
    for (int i = 0; i < 18; ++i) a.in[i] = (const float*)d_in[i];
    a.out = (float*)d_out; a.ws = (unsigned char*)d_ws;
    hipLaunchKernelGGL(fwd_kernel, dim3(grid), dim3(NWAVES * 64), LDS_BYTES, stream, a);
    const hipError_t le = hipPeekAtLastError();
    if (le != hipSuccess) fprintf(stderr, "kernel_launch: launch failed: %s\n", hipGetErrorName(le));
}
```
